# Optimizing an MI355X kernel written in HIP

```python
import math
import jax, jax.numpy as jnp
from jax import lax
import numpy as np

D_MODEL = 1024
BATCH = 2
SEQ = 8192
DEPTH = 4

HEAD_DIM = 64
BLOCK = 128
ROPE_THETA = 10000.0
EPS = 1e-6
NEG = -1e30
N_BRANCH = 3
BRANCH_WIDTH = D_MODEL // 4

SB_HEADS = BRANCH_WIDTH // HEAD_DIM

MLA_HEADS = 4
MLA_V = BRANCH_WIDTH // MLA_HEADS
MLA_NOPE = 64
MLA_ROPE = 32
MLA_Q_LORA = D_MODEL // 4
MLA_KV_LORA = D_MODEL // 8

DIL_CONFIGS = ((128, 1), (512, 4), (2048, 16))
DIL_HEADS = BRANCH_WIDTH // HEAD_DIM

SB_COLS = 3 * SB_HEADS * HEAD_DIM
MLA_COLS = MLA_Q_LORA + MLA_KV_LORA + MLA_ROPE
DIL_COLS = len(DIL_CONFIGS) * 3 * DIL_HEADS * HEAD_DIM
GATE_COLS = N_BRANCH * D_MODEL
IN_COLS = SB_COLS + MLA_COLS + DIL_COLS + GATE_COLS

N_GROUPS = 4
EXPERTS_PER_GROUP = 4
N_EXPERTS = N_GROUPS * EXPERTS_PER_GROUP
TOP_K = 2
D_EXPERT = D_MODEL // 4

kernel_name = "hybrid_sb_mla_dilated_hmoe"


def rmsnorm(x, g):
    xf = x.astype(jnp.float32)
    y = xf * lax.rsqrt(jnp.mean(xf * xf, axis=-1, keepdims=True) + EPS)
    return (y * g.astype(jnp.float32)).astype(x.dtype)


def apply_rope(x, pos):
    dim = x.shape[-1]
    inv_freq = ROPE_THETA ** (-jnp.arange(0, dim, 2, dtype=jnp.float32) / dim)
    ang = pos.astype(jnp.float32)[:, :, None, None] * inv_freq
    cos, sin = jnp.cos(ang), jnp.sin(ang)
    x1, x2 = jnp.split(x.astype(jnp.float32), 2, axis=-1)
    return jnp.concatenate([x1 * cos - x2 * sin, x1 * sin + x2 * cos], axis=-1).astype(x.dtype)


def query_blocks(t):
    b, s, h, d = t.shape
    return t.reshape(b, s // BLOCK, BLOCK, h, d).transpose(1, 0, 2, 3, 4)


def merge_blocks(t):
    nb, b, q, h, d = t.shape
    return t.transpose(1, 0, 2, 3, 4).reshape(b, nb * q, h, d)


def stick_breaking_attention(q, k, v):
    b, s, h, dh = q.shape
    scale = dh ** -0.5
    key_pos = jnp.arange(s)
    starts = jnp.arange(s // BLOCK) * BLOCK

    def one_block(args):
        q_blk, start = args
        z = jnp.einsum('bqhd,bkhd->bhqk', q_blk, k, preferred_element_type=jnp.float32) * scale
        qpos = start + jnp.arange(BLOCK)
        strict = key_pos[None, :] < qpos[:, None]
        log_beta = jax.nn.log_sigmoid(z)
        log_one_minus = jnp.where(strict, jax.nn.log_sigmoid(-z), 0.0)
        after = lax.cumsum(log_one_minus, axis=3, reverse=True) - log_one_minus
        w = jnp.where(strict, jnp.exp(log_beta + after), 0.0)
        return jnp.einsum('bhqk,bkhd->bqhd', w.astype(v.dtype), v)

    return merge_blocks(lax.map(one_block, (query_blocks(q), starts)))


def mla_attention(c_q, c_kv, k_rope_raw, pos, g_q_lat, w_uq, g_kv_lat, w_ukv):
    b, s, _ = c_q.shape
    q = (rmsnorm(c_q, g_q_lat) @ w_uq).reshape(b, s, MLA_HEADS, MLA_NOPE + MLA_ROPE)
    q_nope = q[..., :MLA_NOPE]
    q_rope = apply_rope(q[..., MLA_NOPE:], pos)
    kv = (rmsnorm(c_kv, g_kv_lat) @ w_ukv).reshape(b, s, MLA_HEADS, MLA_NOPE + MLA_V)
    k_nope, v = kv[..., :MLA_NOPE], kv[..., MLA_NOPE:]
    k_rope = apply_rope(k_rope_raw[:, :, None, :], pos)[:, :, 0]
    scale = (MLA_NOPE + MLA_ROPE) ** -0.5
    key_pos = jnp.arange(s)
    starts = jnp.arange(s // BLOCK) * BLOCK

    def one_block(args):
        qn, qr, start = args
        sc = (jnp.einsum('bqhd,bkhd->bhqk', qn, k_nope, preferred_element_type=jnp.float32)
              + jnp.einsum('bqhd,bkd->bhqk', qr, k_rope, preferred_element_type=jnp.float32)) * scale
        qpos = start + jnp.arange(BLOCK)
        causal = key_pos[None, :] <= qpos[:, None]
        p = jax.nn.softmax(jnp.where(causal, sc, NEG), axis=-1)
        return jnp.einsum('bhqk,bkhd->bqhd', p.astype(v.dtype), v)

    return merge_blocks(lax.map(one_block, (query_blocks(q_nope), query_blocks(q_rope), starts)))


def dilated_group_attention(q, k, v, window, dilation):
    b, s, h, dh = q.shape
    L = window // dilation
    s_pad = -(-s // window) * window
    n = s_pad // dilation
    nb = n // L

    def strided_blocks(t):
        t = jnp.pad(t, ((0, 0), (0, s_pad - s), (0, 0), (0, 0)))
        t = t.reshape(b, n, dilation, h, dh).transpose(0, 2, 1, 3, 4)
        return t.reshape(b, dilation, nb, L, h, dh)

    qb, kb, vb = strided_blocks(q), strided_blocks(k), strided_blocks(v)
    prev = lambda t: jnp.pad(t, ((0, 0), (0, 0), (1, 0), (0, 0), (0, 0), (0, 0)))[:, :, :-1]
    kw = jnp.concatenate([prev(kb), kb], axis=3)
    vw = jnp.concatenate([prev(vb), vb], axis=3)
    sc = jnp.einsum('brnqhd,brnkhd->brnhqk', qb, kw, preferred_element_type=jnp.float32) * (dh ** -0.5)
    a = jnp.arange(L)[:, None]
    c = jnp.arange(2 * L)[None, :]
    band = (c >= a) & (c <= a + L)
    has_prev = jnp.arange(nb) > 0
    valid = band[None] & ((c >= L)[None] | has_prev[:, None, None])
    sc = jnp.where(valid[None, None, :, None], sc, NEG)
    lse = jax.nn.logsumexp(sc, axis=-1)
    p = jnp.exp(sc - lse[..., None])
    o = jnp.einsum('brnhqk,brnkhd->brnqhd', p.astype(v.dtype), vw)
    o = o.reshape(b, dilation, n, h, dh).transpose(0, 2, 1, 3, 4).reshape(b, s_pad, h, dh)[:, :s]
    lse = lse.transpose(0, 1, 2, 4, 3).reshape(b, dilation, n, h).transpose(0, 2, 1, 3).reshape(b, s_pad, h)[:, :s]
    return o, lse


def hybrid_mixer(h, pos, w_in, g_q_lat, w_uq, g_kv_lat, w_ukv, w_branch, w_out):
    b, s, _ = h.shape
    proj = h @ w_in
    sb, mla, dil, gate_logits = jnp.split(
        proj, [SB_COLS, SB_COLS + MLA_COLS, SB_COLS + MLA_COLS + DIL_COLS], axis=-1)

    sb = sb.reshape(b, s, 3, SB_HEADS, HEAD_DIM)
    o_a = stick_breaking_attention(sb[:, :, 0], sb[:, :, 1], sb[:, :, 2])

    c_q, c_kv, k_rope_raw = jnp.split(mla, [MLA_Q_LORA, MLA_Q_LORA + MLA_KV_LORA], axis=-1)
    o_b = mla_attention(c_q, c_kv, k_rope_raw, pos, g_q_lat, w_uq, g_kv_lat, w_ukv)

    dil = dil.reshape(b, s, len(DIL_CONFIGS), 3, DIL_HEADS, HEAD_DIM)
    outs, lses = [], []
    for gi, (window, dilation) in enumerate(DIL_CONFIGS):
        qg = apply_rope(dil[:, :, gi, 0], pos)
        kg = apply_rope(dil[:, :, gi, 1], pos)
        o_g, lse_g = dilated_group_attention(qg, kg, dil[:, :, gi, 2], window, dilation)
        outs.append(o_g)
        lses.append(lse_g)
    alpha = jax.nn.softmax(jnp.stack(lses, axis=0), axis=0)
    o_c = jnp.sum(alpha[..., None] * jnp.stack(outs, axis=0).astype(jnp.float32), axis=0).astype(h.dtype)

    branches = jnp.stack([o_a.reshape(b, s, BRANCH_WIDTH),
                          o_b.reshape(b, s, BRANCH_WIDTH),
                          o_c.reshape(b, s, BRANCH_WIDTH)], axis=2)
    branch_d = jnp.einsum('bsnc,ncd->bsnd', branches, w_branch)
    gates = jax.nn.sigmoid(gate_logits.reshape(b, s, N_BRANCH, D_MODEL).astype(jnp.float32)).astype(h.dtype)
    merged = jnp.sum(gates * branch_d, axis=2)
    return merged @ w_out


def hierarchical_moe(h, w_group_router, b_group_router, w_expert_router, b_expert_router,
                     w_gate, w_up, w_down):
    b, s, d = h.shape
    t = h.reshape(b * s, d)
    group_logits = (t @ w_group_router).astype(jnp.float32) + b_group_router.astype(jnp.float32)
    group_prob = jax.nn.softmax(group_logits, axis=-1)
    g_top = jnp.argmax(group_logits, axis=-1)
    p_group = jnp.take_along_axis(group_prob, g_top[:, None], axis=-1)
    expert_logits = ((t @ w_expert_router).astype(jnp.float32)
                     + b_expert_router.astype(jnp.float32)).reshape(-1, N_GROUPS, EXPERTS_PER_GROUP)
    in_group = jnp.take_along_axis(expert_logits, g_top[:, None, None], axis=1)[:, 0]
    top_logit, top_i = lax.top_k(in_group, TOP_K)
    top_p = jax.nn.softmax(top_logit, axis=-1)
    expert_ids = g_top[:, None] * EXPERTS_PER_GROUP + top_i
    weights = p_group * top_p
    combine = jnp.sum(jax.nn.one_hot(expert_ids, N_EXPERTS, dtype=jnp.float32) * weights[..., None], axis=1)
    hid = jax.nn.silu(jnp.einsum('td,edf->tef', t, w_gate)) * jnp.einsum('td,edf->tef', t, w_up)
    out = jnp.einsum('tef,efd->td', hid * combine[:, :, None].astype(hid.dtype), w_down)
    return out.reshape(b, s, d)


def setup_inputs(seed: int = 0) -> dict:
    key = jax.random.key(seed)
    ks = jax.random.split(key, 24)
    f32 = jnp.float32

    def nrm(k, shape, fan_in):
        return jax.random.normal(k, shape, f32) * (fan_in ** -0.5)

    def gain(k, shape):
        return 1.0 + 0.02 * jax.random.normal(k, shape, f32)

    x = jax.random.normal(ks[0], (BATCH, SEQ, D_MODEL), f32)
    offset = jax.random.randint(ks[1], (BATCH, 1), 0, 4096, dtype=jnp.int32)
    positions = offset + jnp.arange(SEQ, dtype=jnp.int32)[None, :]
    return {
        "x": x,
        "positions": positions,
        "g_mix": gain(ks[2], (DEPTH, D_MODEL)),
        "w_in": nrm(ks[3], (DEPTH, D_MODEL, IN_COLS), D_MODEL),
        "g_q_lat": gain(ks[4], (DEPTH, MLA_Q_LORA)),
        "w_uq": nrm(ks[5], (DEPTH, MLA_Q_LORA, MLA_HEADS * (MLA_NOPE + MLA_ROPE)), MLA_Q_LORA),
        "g_kv_lat": gain(ks[6], (DEPTH, MLA_KV_LORA)),
        "w_ukv": nrm(ks[7], (DEPTH, MLA_KV_LORA, MLA_HEADS * (MLA_NOPE + MLA_V)), MLA_KV_LORA),
        "w_branch": nrm(ks[8], (DEPTH, N_BRANCH, BRANCH_WIDTH, D_MODEL), BRANCH_WIDTH),
        "w_out": nrm(ks[9], (DEPTH, D_MODEL, D_MODEL), D_MODEL),
        "g_ffn": gain(ks[10], (DEPTH, D_MODEL)),
        "w_group_router": nrm(ks[11], (DEPTH, D_MODEL, N_GROUPS), D_MODEL),
        "b_group_router": 0.01 * jax.random.normal(ks[12], (DEPTH, N_GROUPS), f32),
        "w_expert_router": nrm(ks[13], (DEPTH, D_MODEL, N_EXPERTS), D_MODEL),
        "b_expert_router": 0.01 * jax.random.normal(ks[14], (DEPTH, N_EXPERTS), f32),
        "w_gate": nrm(ks[15], (DEPTH, N_EXPERTS, D_MODEL, D_EXPERT), D_MODEL),
        "w_up": nrm(ks[16], (DEPTH, N_EXPERTS, D_MODEL, D_EXPERT), D_MODEL),
        "w_down": nrm(ks[17], (DEPTH, N_EXPERTS, D_EXPERT, D_MODEL), D_EXPERT),
        "g_final": gain(ks[18], (D_MODEL,)),
    }


def reference(x, positions, g_mix, w_in, g_q_lat, w_uq, g_kv_lat, w_ukv, w_branch, w_out, g_ffn,
              w_group_router, b_group_router, w_expert_router, b_expert_router,
              w_gate, w_up, w_down, g_final):
    for l in range(DEPTH):
        h = rmsnorm(x, g_mix[l])
        x = x + hybrid_mixer(h, positions, w_in[l], g_q_lat[l], w_uq[l], g_kv_lat[l], w_ukv[l],
                             w_branch[l], w_out[l])
        h = rmsnorm(x, g_ffn[l])
        x = x + hierarchical_moe(h, w_group_router[l], b_group_router[l], w_expert_router[l],
                                 b_expert_router[l], w_gate[l], w_up[l], w_down[l])
    return rmsnorm(x, g_final)
```

```cpp
#include <hip/hip_runtime.h>
#include <cstdio>
#include <cstdint>

#ifndef MK_PER_PHASE
#define MK_PER_PHASE 1
#endif

#define LAS __attribute__((address_space(3)))
#define GAS __attribute__((address_space(1)))
typedef unsigned short bf16;
typedef short bf16x8 __attribute__((ext_vector_type(8)));
typedef short s16x4 __attribute__((ext_vector_type(4)));
typedef float f32x2 __attribute__((ext_vector_type(2)));
typedef float f32x4 __attribute__((ext_vector_type(4)));
typedef float f32x16 __attribute__((ext_vector_type(16)));
typedef unsigned u32x2 __attribute__((ext_vector_type(2)));
typedef unsigned u32x4 __attribute__((ext_vector_type(4)));
typedef __bf16 bf2_t __attribute__((ext_vector_type(2)));
typedef short v4i16_t __attribute__((ext_vector_type(4)));

#define DI __device__ __forceinline__
DI unsigned pk2(float a, float b) { f32x2 v = {a, b}; return __builtin_bit_cast(unsigned, __builtin_convertvector(v, bf2_t)); }
DI float bflo(unsigned u) { return __uint_as_float(u << 16); }
DI float bfhi(unsigned u) { return __uint_as_float(u & 0xffff0000u); }
DI float fexp2(float x) { return __builtin_amdgcn_exp2f(x); }
DI float flog2(float x) { return __builtin_amdgcn_logf(x); }
DI float frcp(float x) { return __builtin_amdgcn_rcpf(x); }

constexpr int T = 16384, D = 1024, SEQ = 8192, NLAYER = 4;
constexpr int NPROJ = 6656;
constexpr int PJ_SB = 0, PJ_MLA = 768, PJ_KR = 1152, PJ_DIL = 1280, PJ_GATE = 3584;
constexpr int INC = 6560;
constexpr float EPS = 1e-6f;
constexpr float LOG2E = 1.4426950408889634f;
constexpr float C_SB = 0.125f * LOG2E;
constexpr float C_MLA = 0.10206207261596577f * LOG2E;
constexpr int MROWS = 36864;

namespace pg8 {
constexpr int BM = 256, BK = 64, HALF = 128, HTB = HALF * BK * 2, STAGE_BYTES = 8 * HTB, NXCD = 8, WGM = 8;
__host__ __device__ __forceinline__ int lds_byte(int r, int c) { const int st = (r >> 4) * 2 + (c >> 5), rr = r & 15, cc = c & 31, ob = rr * 64 + cc * 2; return st * 1024 + (ob ^ (((ob >> 9) & 1) << 5)); }
__host__ __device__ __forceinline__ void stage_rc(int b, int& R, int& C) { const int st = b / 1024, sb = b % 1024, swz = sb ^ (((sb >> 9) & 1) << 5); R = (st >> 1) * 16 + swz / 64; C = (st & 1) * 32 + (swz % 64) / 2; }
__host__ __device__ __forceinline__ int perm32(int rho) { const int n = rho >> 4, i = rho & 15; return 8 * (i >> 2) + 4 * n + (i & 3); }

struct Unit { int pm, pn, ka; };
struct Gemm { const bf16* A; const bf16* Bt; int lda, ldb, K; };

struct StaticOrder {
    int nM, nN, nwg, G, c;
    __device__ void init(int M, int N, int G_, int c_) { nM = M / BM; nN = N / BM; nwg = nM * nN; G = G_; c = c_; }
    __device__ bool next(int i, Unit& u) const {
        const long L = (long)i * G + c; if (L >= nwg) return false;
        int wgid = (int)L; { const int q = nwg / NXCD, r = nwg % NXCD, xcd = wgid % NXCD, off = wgid / NXCD; wgid = (xcd < r ? xcd * (q + 1) : r * (q + 1) + (xcd - r) * q) + off; }
        const int nig = WGM * nN, gid = wgid / nig, fm = gid * WGM, gsz = (nM - fm) < WGM ? (nM - fm) : WGM;
        u.pm = fm + ((wgid % nig) % gsz); u.pn = (wgid % nig) / gsz; u.ka = 0; return true;
    }
};

template <class Epi, class Sched, bool ALIGN_EPI>
__device__ __forceinline__ void gemm_phase(LAS unsigned char* lds, const int tid, const Gemm g, const Sched& S, const Epi& E) {
    const int wid = __builtin_amdgcn_readfirstlane(tid >> 6), lane = tid & 63, wr = wid >> 2, wc = wid & 3, fr = lane & 15, fq = lane >> 4;
    const int K = g.K, nt = K / BK;
    unsigned voffA[2], voffB[2];
#pragma unroll
    for (int i = 0; i < 2; ++i) { int R, C; stage_rc(tid * 16 + i * 8192, R, C); const int Rb = Epi::PERM ? ((R & ~31) + perm32(R & 31)) : R;
        voffA[i] = (unsigned)(R * g.lda + C) * 2u; voffB[i] = (unsigned)(Rb * g.ldb + C) * 2u; }
    const size_t kstep = (size_t)(BK * 2);
    const size_t hstepA = (size_t)HALF * g.lda * 2, hstepB = (size_t)HALF * g.ldb * 2;
    const size_t tstepA = 2 * hstepA, tstepB = 2 * hstepB;
    const unsigned ldsw = (unsigned)wid * 1024u;
    const int aoff = lds_byte(wr * 64 + fr, fq * 8), boff = lds_byte(wc * 32 + fr, fq * 8);
#define PG8_SA(b, h) (((b) * 2 + (h)) * HTB)
#define PG8_SB(b, h) ((4 + (b) * 2 + (h)) * HTB)
#define PG8_STAGE(bufoff, gbase, voff) do { _Pragma("unroll") for (int _i = 0; _i < 2; ++_i) \
        __builtin_amdgcn_global_load_lds((const unsigned*)((const char*)(gbase) + (voff)[_i]), (LAS unsigned*)(lds + (bufoff) + ldsw + _i * 8192), 16, 0, 0); } while (0)
#define PG8_LDA(dst, b, h) do { _Pragma("unroll") for (int m = 0; m < 4; ++m) _Pragma("unroll") for (int k = 0; k < 2; ++k) dst[m][k] = *(const LAS bf16x8*)(lds + PG8_SA(b, h) + aoff + m * 2048 + k * 1024); } while (0)
#define PG8_LDB(dst, b, h) do { _Pragma("unroll") for (int n = 0; n < 2; ++n) _Pragma("unroll") for (int k = 0; k < 2; ++k) dst[n][k] = *(const LAS bf16x8*)(lds + PG8_SB(b, h) + boff + n * 2048 + k * 1024); } while (0)
#define PG8_MMA(ai, bj, At, Bt) do { __builtin_amdgcn_s_setprio(1); _Pragma("unroll") for (int m = 0; m < 4; ++m) _Pragma("unroll") for (int n = 0; n < 2; ++n) _Pragma("unroll") for (int k = 0; k < 2; ++k) \
        acc[ai][bj][m][n] = __builtin_amdgcn_mfma_f32_16x16x32_bf16(Bt[n][k], At[m][k], acc[ai][bj][m][n], 0, 0, 0); __builtin_amdgcn_s_setprio(0); } while (0)
#define PG8_WAIT_V(n) asm volatile("s_waitcnt vmcnt(" #n ")" ::: "memory")
#define PG8_WAIT_L(n) asm volatile("s_waitcnt lgkmcnt(" #n ")" ::: "memory")
#define PG8_BAR __builtin_amdgcn_s_barrier()
#define PG8_SCHED __builtin_amdgcn_sched_barrier(0)
    Unit cur, nxt; int ui = 0;
    if (!S.next(0, cur)) return;
    f32x4 acc[2][2][4][2];
#pragma unroll
    for (int a = 0; a < 2; ++a)
#pragma unroll
        for (int b = 0; b < 2; ++b)
#pragma unroll
            for (int m = 0; m < 4; ++m)
#pragma unroll
                for (int n = 0; n < 2; ++n) acc[a][b][m][n] = (f32x4){0.f, 0.f, 0.f, 0.f};
    bf16x8 At[4][2], B0[2][2], B1[2][2];
    const char* cA = (const char*)g.A + (size_t)cur.pm * tstepA + (size_t)cur.ka * 2; const char* cB = (const char*)g.Bt + (size_t)cur.pn * tstepB;
    PG8_STAGE(PG8_SB(0, 0), cB, voffB); PG8_STAGE(PG8_SB(0, 1), cB + hstepB, voffB); PG8_STAGE(PG8_SA(0, 0), cA, voffA); PG8_STAGE(PG8_SA(0, 1), cA + hstepA, voffA);
    if (wr == 1) PG8_BAR;
    PG8_WAIT_V(2); PG8_BAR;
    PG8_STAGE(PG8_SB(1, 0), cB + kstep, voffB); PG8_STAGE(PG8_SA(1, 0), cA + kstep, voffA); PG8_STAGE(PG8_SB(1, 1), cB + hstepB + kstep, voffB);
    PG8_WAIT_V(6); PG8_BAR;
    for (;;) {
        const bool has_next = S.next(ui + 1, nxt);
        const char* nA = has_next ? (const char*)g.A + (size_t)nxt.pm * tstepA + (size_t)nxt.ka * 2 : cA; const char* nB = has_next ? (const char*)g.Bt + (size_t)nxt.pn * tstepB : cB;
#pragma unroll 1
        for (int t = 0; t < nt; t += 2) {
            const bool last = (t == nt - 2);
            const char* a1 = cA + (size_t)(t + 1) * kstep;
            const char* a2 = last ? nA : cA + (size_t)(t + 2) * kstep; const char* b2 = last ? nB : cB + (size_t)(t + 2) * kstep;
            const char* a3 = a2 + kstep; const char* b3 = b2 + kstep;
            PG8_LDB(B0, 0, 0); PG8_LDB(B1, 0, 1); PG8_SCHED; PG8_LDA(At, 0, 0); PG8_STAGE(PG8_SA(1, 1), a1 + hstepA, voffA);
            PG8_WAIT_V(8); PG8_WAIT_L(0); PG8_BAR; PG8_MMA(0, 0, At, B0); PG8_MMA(0, 1, At, B1); PG8_BAR; PG8_SCHED;
            PG8_LDA(At, 0, 1); PG8_STAGE(PG8_SB(0, 0), b2, voffB); PG8_STAGE(PG8_SB(0, 1), b2 + hstepB, voffB); PG8_STAGE(PG8_SA(0, 0), a2, voffA);
            PG8_WAIT_V(8); PG8_WAIT_L(0); PG8_BAR; PG8_MMA(1, 0, At, B0); PG8_MMA(1, 1, At, B1); PG8_BAR; PG8_SCHED;
            PG8_LDB(B0, 1, 0); PG8_LDB(B1, 1, 1); PG8_SCHED; PG8_LDA(At, 1, 0); PG8_STAGE(PG8_SA(0, 1), a2 + hstepA, voffA);
            PG8_WAIT_V(8); PG8_WAIT_L(0); PG8_BAR; PG8_MMA(0, 0, At, B0); PG8_MMA(0, 1, At, B1); PG8_BAR; PG8_SCHED;
            PG8_LDA(At, 1, 1); PG8_STAGE(PG8_SB(1, 0), b3, voffB); PG8_STAGE(PG8_SB(1, 1), b3 + hstepB, voffB); PG8_STAGE(PG8_SA(1, 0), a3, voffA);
            PG8_WAIT_V(8); PG8_WAIT_L(0); PG8_BAR; PG8_MMA(1, 0, At, B0); PG8_MMA(1, 1, At, B1); PG8_BAR; PG8_SCHED;
        }
        if constexpr (ALIGN_EPI) { if (wr == 0) PG8_BAR; }
        E(acc, cur, wr, wc, fr, fq);
        if (!has_next) break;
        if (!E.keep(cur)) {
#pragma unroll
            for (int a = 0; a < 2; ++a)
#pragma unroll
                for (int b = 0; b < 2; ++b)
#pragma unroll
                    for (int m = 0; m < 4; ++m)
#pragma unroll
                        for (int n = 0; n < 2; ++n) acc[a][b][m][n] = (f32x4){0.f, 0.f, 0.f, 0.f};
        }
        cur = nxt; cA = nA; cB = nB; ++ui;
        if constexpr (ALIGN_EPI) { if (wr == 1) PG8_BAR; }
    }
    PG8_WAIT_V(0);
    if constexpr (!ALIGN_EPI) { if (wr == 0) PG8_BAR; }
    PG8_BAR;
#undef PG8_SA
#undef PG8_SB
#undef PG8_STAGE
#undef PG8_LDA
#undef PG8_LDB
#undef PG8_MMA
#undef PG8_WAIT_V
#undef PG8_WAIT_L
#undef PG8_BAR
#undef PG8_SCHED
}
}
using pg8::Unit;

constexpr size_t MiB = 1u << 20;
constexpr size_t WS_CTL = 0, CTL_ZERO_BYTES = 1 * MiB;
constexpr size_t WS_RT = 1 * MiB;
constexpr size_t RT_E = 0, RT_W = 131072, RT_RANK = 262144, RT_POS = 393216, RT_CNT = 524288;
constexpr size_t WS_CS64 = 4 * MiB, WS_CS32 = 8 * MiB;
constexpr size_t WS_WIN = 10 * MiB, WS_WUP = 23 * MiB, WS_WB = 24 * MiB, WS_WOUT = 26 * MiB, WS_W1 = 28 * MiB, WS_W2 = 44 * MiB;
constexpr size_t WS_H = 52 * MiB;
constexpr size_t WS_MQ = 84 * MiB;
constexpr size_t WS_OBR = 116 * MiB;
constexpr size_t WS_PROJ = 140 * MiB;
constexpr size_t WS_HPERM = 140 * MiB, WS_HID = 212 * MiB, WS_YBUF = 230 * MiB;
constexpr size_t WS_END = 348 * MiB;
static_assert(WS_WIN + (size_t)NPROJ * 1024 * 2 <= WS_WUP && WS_YBUF + (size_t)MROWS * 1024 * 2 <= WS_END && WS_HPERM + (size_t)MROWS * 1024 * 2 <= WS_HID && WS_HID + (size_t)MROWS * 256 * 2 <= WS_YBUF, "ws map");
static_assert(WS_PROJ + (size_t)T * NPROJ * 2 <= WS_END, "ws map 2");
constexpr int CW_BAR = 4096, CW_Q = 8192;

constexpr int RING_BYTES = 131072;
constexpr int LDSCTL_OFF = RING_BYTES;
constexpr int LC_XB = 0, LC_Q = 16, LC_TS = 64  , LC_TOT = 192  , LC_BASE = 256  , LC_SEG = 320  ;
constexpr int LDS_BYTES = 147456;

#define XB_TMO      128
#define XB_XCNT(j)  (256  + 64 * (j))
#define XB_XSUB(j)  (1280 + 64 * (j))
#define XB_XGEN(j)  (2304 + 64 * (j))
#define XB_TOP      3328
#define XB_TOPGEN   3392
#define XCD_BAR_WORDS 3456
#define XB_SPIN_CAP (1u << 18)
DI unsigned xb_ld(unsigned* p)              { return __hip_atomic_load(p, __ATOMIC_RELAXED, __HIP_MEMORY_SCOPE_AGENT); }
DI unsigned xb_add(unsigned* p, unsigned v) { return __hip_atomic_fetch_add(p, v, __ATOMIC_RELAXED, __HIP_MEMORY_SCOPE_AGENT); }
DI unsigned xb_xcc_id() { return (unsigned)__builtin_amdgcn_s_getreg((3 << 11) | 20) & 0xFu; }
#define XB_SPIN(cond, bar) do { unsigned _sp = 0; while (cond) { __builtin_amdgcn_s_sleep(1); \
    if ((++_sp & 255u) == 0u) { if (xb_ld(&(bar)[XB_TMO])) break; if (_sp > XB_SPIN_CAP) { atomicAdd(&(bar)[XB_TMO], 1u); break; } } } } while (0)
struct XcdBarrier { unsigned* bar; unsigned x; volatile LAS unsigned* st; };
DI XcdBarrier xcd_barrier_post(unsigned* bar, volatile LAS unsigned* st) {
    XcdBarrier b; b.bar = bar; b.x = xb_xcc_id(); b.st = st;
    if (threadIdx.x == 0) (void)xb_add(&bar[XB_XCNT(b.x)], 1u);
    return b;
}
DI void xcd_barrier_complete(unsigned* bar, unsigned x, unsigned& nloc, unsigned& nx) {
    const unsigned G = gridDim.x * gridDim.y * gridDim.z;
    unsigned sum, cnt, mine, sp = 0u;
    for (;;) {
        sum = 0u; cnt = 0u; mine = 0u;
#pragma unroll
        for (unsigned j = 0; j < 16; ++j) { const unsigned c = xb_ld(&bar[XB_XCNT(j)]); sum += c; cnt += (c > 0u) ? 1u : 0u; mine = (j == x) ? c : mine; }
        if (sum == G) break;
        __builtin_amdgcn_s_sleep(1);
        if ((++sp & 255u) == 0u) { if (xb_ld(&bar[XB_TMO])) break; if (sp > XB_SPIN_CAP) { atomicAdd(&bar[XB_TMO], 1u); break; } }
    }
    nloc = mine > 0u ? mine : 1u; nx = cnt > 0u ? cnt : 1u;
}
DI void xcd_barrier(const XcdBarrier& b) {
    asm volatile("s_waitcnt vmcnt(0)" ::: "memory");
    __syncthreads();
    if (threadIdx.x == 0) {
        unsigned* bar = b.bar;
        __builtin_amdgcn_s_waitcnt(0);
        unsigned nloc = b.st[0], nx = b.st[1];
        if (nloc == 0u) { xcd_barrier_complete(bar, b.x, nloc, nx); b.st[0] = nloc; b.st[1] = nx; }
        const unsigned old = xb_add(&bar[XB_XSUB(b.x)], 1u);
        const unsigned gen = old / nloc;
        if (old + 1u == (gen + 1u) * nloc) {
            __builtin_amdgcn_fence(__ATOMIC_RELEASE, "agent");
            asm volatile("s_waitcnt vmcnt(0)" ::: "memory");
            const unsigned og = xb_add(&bar[XB_TOP], 1u);
            const unsigned tg = og / nx;
            if (og + 1u == (tg + 1u) * nx) xb_add(&bar[XB_TOPGEN], 1u);
            else XB_SPIN(xb_ld(&bar[XB_TOPGEN]) == tg, bar);
            __builtin_amdgcn_fence(__ATOMIC_ACQUIRE, "agent");
            xb_add(&bar[XB_XGEN(b.x)], 1u);
            asm volatile("s_waitcnt vmcnt(0)" ::: "memory");
        } else {
            XB_SPIN(xb_ld(&bar[XB_XGEN(b.x)]) == gen, bar);
            __builtin_amdgcn_fence(__ATOMIC_ACQUIRE, "agent");
            asm volatile("s_waitcnt vmcnt(0)" ::: "memory");
        }
    }
    __syncthreads();
}

struct Args { const void* in[19]; float* out; unsigned char* ws; int ph_lo, ph_hi; };
struct Frame {
    LAS unsigned char* lds;
    unsigned char* ws; float* out;
    const __attribute__((address_space(4))) Args* ap;
    int tid, lane, wave, vcu, G, bx;
};
DI Frame mkframe() {
    extern __shared__ __attribute__((aligned(16))) unsigned char lds_raw[];
    Frame F;
    F.lds = (LAS unsigned char*)lds_raw;
    int t = threadIdx.x; asm volatile("" : "+v"(t));
    F.tid = t; F.lane = t & 63; F.wave = __builtin_amdgcn_readfirstlane(t >> 6);
    int bx = blockIdx.x, G = gridDim.x; asm volatile("" : "+s"(bx), "+s"(G));
    F.bx = bx; F.G = G; F.vcu = (G % 8 == 0) ? (bx % 8) * (G / 8) + bx / 8 : bx;
    const __attribute__((address_space(4))) Args* ap = (const __attribute__((address_space(4))) Args*)__builtin_amdgcn_kernarg_segment_ptr();
    asm volatile("" : "+s"(ap));
    F.ap = ap; F.ws = ap->ws; F.out = ap->out;
    return F;
}
#define FIN(F, k, ty) ((const ty*)(F).ap->in[k])
#define F_x(F) FIN(F, 0, float)
#define F_pos(F) FIN(F, 1, int)
#define F_g_mix(F) FIN(F, 2, float)
#define F_w_in(F) FIN(F, 3, float)
#define F_g_q_lat(F) FIN(F, 4, float)
#define F_w_uq(F) FIN(F, 5, float)
#define F_g_kv_lat(F) FIN(F, 6, float)
#define F_w_ukv(F) FIN(F, 7, float)
#define F_w_branch(F) FIN(F, 8, float)
#define F_w_out(F) FIN(F, 9, float)
#define F_g_ffn(F) FIN(F, 10, float)
#define F_w_gr(F) FIN(F, 11, float)
#define F_b_gr(F) FIN(F, 12, float)
#define F_w_er(F) FIN(F, 13, float)
#define F_b_er(F) FIN(F, 14, float)
#define F_w_gate(F) FIN(F, 15, float)
#define F_w_up(F) FIN(F, 16, float)
#define F_w_down(F) FIN(F, 17, float)
#define F_g_final(F) FIN(F, 18, float)
#define F_ctl(F) ((unsigned*)((F).ws + WS_CTL))
#define F_tok_e(F) ((int*)((F).ws + WS_RT + RT_E))
#define F_tok_w(F) ((float*)((F).ws + WS_RT + RT_W))
#define F_tok_rank(F) ((int*)((F).ws + WS_RT + RT_RANK))
#define F_tok_pos(F) ((int*)((F).ws + WS_RT + RT_POS))
#define F_blk_cnt(F) ((int*)((F).ws + WS_RT + RT_CNT))
#define F_cs64(F) ((float*)((F).ws + WS_CS64))
#define F_cs32(F) ((float*)((F).ws + WS_CS32))
#define F_Win_t(F) ((bf16*)((F).ws + WS_WIN))
#define F_Wup_t(F) ((bf16*)((F).ws + WS_WUP))
#define F_Wb_t(F) ((bf16*)((F).ws + WS_WB))
#define F_Wout_t(F) ((bf16*)((F).ws + WS_WOUT))
#define F_W1_t(F) ((bf16*)((F).ws + WS_W1))
#define F_W2_t(F) ((bf16*)((F).ws + WS_W2))
#define F_H(F) ((bf16*)((F).ws + WS_H))
#define F_MQ(F) ((bf16*)((F).ws + WS_MQ))
#define F_OBR(F) ((bf16*)((F).ws + WS_OBR))
#define F_PROJ(F) ((bf16*)((F).ws + WS_PROJ))
#define F_HPERM(F) ((bf16*)((F).ws + WS_HPERM))
#define F_HID(F) ((bf16*)((F).ws + WS_HID))
#define F_YBUF(F) ((bf16*)((F).ws + WS_YBUF))
#define LDS_WAIT() asm volatile("s_waitcnt lgkmcnt(0)" ::: "memory")
DI float wave_sum(float v) {
#pragma unroll
    for (int o = 1; o < 64; o <<= 1) v += __shfl_xor(v, o);
    return v;
}

DI void pre_tables(Frame& F) {
    const int gt = F.bx * 512 + F.tid, NT_ = F.G * 512;
    for (int idx = gt; idx < T * 48; idx += NT_) {
        const int t = idx / 48, i = idx % 48;
        const float p = (float)F_pos(F)[t];
        float inv;
        if (i < 32) inv = powf(10000.0f, -(float)(2 * i) / 64.0f); else inv = powf(10000.0f, -(float)(2 * (i - 32)) / 32.0f);
        const float ang = p * inv;
        double rev = (double)ang * 0.15915494309189535; rev -= floor(rev);
        const float rf = (float)rev;
        const float sn = __builtin_amdgcn_sinf(rf), cn = __builtin_amdgcn_cosf(rf);
        if (i < 32) { F_cs64(F)[((size_t)t * 32 + i) * 2] = cn; F_cs64(F)[((size_t)t * 32 + i) * 2 + 1] = sn; }
        else { F_cs32(F)[((size_t)t * 16 + (i - 32)) * 2] = cn; F_cs32(F)[((size_t)t * 16 + (i - 32)) * 2 + 1] = sn; }
    }
}

struct ColSrc { const float* p; int stride; float scale; int klo, khi; const float* kg; };
template <class Map>
DI void conv_item(const Map& mp, int K, int N, bf16* WT, LAS float* scr, int item, int lane) {
    const int nblk = N / 32, kb = item / nblk, nb = item % nblk, k0 = 64 * kb, n0 = 32 * nb;
    const ColSrc cs = mp(n0 + (lane & 31));
#pragma unroll 8
    for (int i = 0; i < 32; ++i) {
        const int kk = 2 * i + (lane >> 5), k = k0 + kk; float v = 0.f;
        if (cs.p != nullptr && k >= cs.klo && k < cs.khi) { v = cs.p[(size_t)(k - cs.klo) * cs.stride] * cs.scale; if (cs.kg) v *= cs.kg[k - cs.klo]; }
        scr[kk * 33 + (lane & 31)] = v;
    }
    LDS_WAIT();
    const int c = lane & 7;
#pragma unroll
    for (int j = 0; j < 4; ++j) { const int n = (lane >> 3) + 8 * j; const LAS float* s = scr + (8 * c) * 33 + n;
        u32x4 o; o.x = pk2(s[0 * 33], s[1 * 33]); o.y = pk2(s[2 * 33], s[3 * 33]); o.z = pk2(s[4 * 33], s[5 * 33]); o.w = pk2(s[6 * 33], s[7 * 33]);
        *(u32x4*)(WT + (size_t)(n0 + n) * K + k0 + 8 * c) = o; }
    LDS_WAIT();
}
struct MapWin { const float* w;
    DI ColSrc operator()(int n) const {
        ColSrc c{nullptr, INC, 1.f, 0, 1024, nullptr};
        if (n < 768) { c.p = w + n; if (n < 256) c.scale = C_SB; }
        else if (n < 1280) { const int j = n - 768; if (j < 384) c.p = w + 768 + j; else if (j < 416) { const int p = j - 384; c.p = w + 1152 + (p >> 1) + 16 * (p & 1); } }
        else if (n < 3584) { const int j = n - 1280, gi = j / 768, rem = j % 768, which = rem >> 8, hd = (rem >> 6) & 3, dd = rem & 63;
            const int sd = which < 2 ? (dd >> 1) + 32 * (dd & 1) : dd; c.p = w + 1184 + gi * 768 + which * 256 + hd * 64 + sd; if (which == 0) c.scale = C_SB; }
        else c.p = w + 3488 + (n - 3584);
        return c; } };
struct MapWup { const float* wuq; const float* wukv; const float* gq; const float* gkv;
    DI ColSrc operator()(int n) const {
        ColSrc c{nullptr, 1, 1.f, 0, 0, nullptr};
        if (n < 384) { const int hd = n / 96, wi = n % 96; const int col = wi < 64 ? hd * 96 + wi : hd * 96 + 64 + ((wi - 64) >> 1) + 16 * ((wi - 64) & 1);
            c.p = wuq + col; c.stride = 384; c.klo = 0; c.khi = 256; c.kg = gq; }
        else if (n < 896) { c.p = wukv + (n - 384); c.stride = 512; c.klo = 256; c.khi = 384; c.kg = gkv; }
        return c; } };
struct MapWb { const float* w;
    DI ColSrc operator()(int n) const { ColSrc c{w + (size_t)(n >> 10) * 256 * 1024 + (n & 1023), 1024, 1.f, 0, 256, nullptr}; return c; } };
struct MapWout { const float* w;
    DI ColSrc operator()(int n) const { ColSrc c{w + n, 1024, 1.f, 0, 1024, nullptr}; return c; } };
struct MapW1 { const float* wg; const float* wu;
    DI ColSrc operator()(int n) const { const int e = n >> 9, rem = n & 511, j = rem >> 8, rr = rem & 255;
        ColSrc c{nullptr, 256, 1.f, 0, 1024, nullptr};
        c.p = (rr < 128) ? wg + (size_t)e * 1024 * 256 + 128 * j + rr : wu + (size_t)e * 1024 * 256 + 128 * j + (rr - 128); return c; } };
struct MapW2 { const float* w;
    DI ColSrc operator()(int n) const { ColSrc c{w + (size_t)(n >> 10) * 256 * 1024 + (n & 1023), 1024, 1.f, 0, 256, nullptr}; return c; } };

DI void conv_phase(Frame& F, int l) {
    LAS float* scr = (LAS float*)(F.lds + F.wave * 16384);
    const int gw = F.vcu * 8 + F.wave, NGW = F.G * 8;
    constexpr int I_IN = 16 * (NPROJ / 32), I_UP = 8 * 32, I_B = 4 * 96, I_O = 16 * 32, I_1 = 16 * 256, I_2 = 4 * 512;
    constexpr int NITEMS = I_IN + I_UP + I_B + I_O + I_1 + I_2;
    const MapWin m_in{F_w_in(F) + (size_t)l * 1024 * INC};
    const MapWup m_up{F_w_uq(F) + (size_t)l * 256 * 384, F_w_ukv(F) + (size_t)l * 128 * 512, F_g_q_lat(F) + l * 256, F_g_kv_lat(F) + l * 128};
    const MapWb m_b{F_w_branch(F) + (size_t)l * 3 * 256 * 1024};
    const MapWout m_o{F_w_out(F) + (size_t)l * 1024 * 1024};
    const MapW1 m_1{F_w_gate(F) + (size_t)l * 16 * 1024 * 256, F_w_up(F) + (size_t)l * 16 * 1024 * 256};
    const MapW2 m_2{F_w_down(F) + (size_t)l * 16 * 256 * 1024};
    for (int it = gw; it < NITEMS; it += NGW) {
        int r = it;
        if (r < I_IN) { conv_item(m_in, 1024, NPROJ, F_Win_t(F), scr, r, F.lane); continue; } r -= I_IN;
        if (r < I_UP) { conv_item(m_up, 512, 1024, F_Wup_t(F), scr, r, F.lane); continue; } r -= I_UP;
        if (r < I_B) { conv_item(m_b, 256, 3072, F_Wb_t(F), scr, r, F.lane); continue; } r -= I_B;
        if (r < I_O) { conv_item(m_o, 1024, 1024, F_Wout_t(F), scr, r, F.lane); continue; } r -= I_O;
        if (r < I_1) { conv_item(m_1, 1024, 8192, F_W1_t(F), scr, r, F.lane); continue; } r -= I_1;
        conv_item(m_2, 256, 16384, F_W2_t(F), scr, r, F.lane);
    }
}

template <bool FINAL>
DI void norm_phase(Frame& F, int l, const float* gain) {
    const int gw = F.vcu * 8 + F.wave, NGW = F.G * 8;
    const float* src = (l == 0) ? F_x(F) : F.out;
    f32x4 g[4];
#pragma unroll
    for (int j = 0; j < 4; ++j) g[j] = *(const f32x4*)(gain + 4 * F.lane + 256 * j);
    for (int m = gw; m < T; m += NGW) {
        f32x4 v[4];
#pragma unroll
        for (int j = 0; j < 4; ++j) v[j] = *(const f32x4*)(src + (size_t)m * D + 4 * F.lane + 256 * j);
        if (l > 0) {
            const int p0 = F_tok_pos(F)[2 * m], p1 = F_tok_pos(F)[2 * m + 1]; const float w0 = F_tok_w(F)[2 * m], w1 = F_tok_w(F)[2 * m + 1];
#pragma unroll
            for (int j = 0; j < 4; ++j) {
                const u32x2 y0 = *(const u32x2*)(F_YBUF(F) + (size_t)p0 * D + 4 * F.lane + 256 * j), y1 = *(const u32x2*)(F_YBUF(F) + (size_t)p1 * D + 4 * F.lane + 256 * j);
                v[j].x += w0 * bflo(y0.x) + w1 * bflo(y1.x); v[j].y += w0 * bfhi(y0.x) + w1 * bfhi(y1.x);
                v[j].z += w0 * bflo(y0.y) + w1 * bflo(y1.y); v[j].w += w0 * bfhi(y0.y) + w1 * bfhi(y1.y);
            }
        }
        float ss = 0.f;
#pragma unroll
        for (int j = 0; j < 4; ++j) ss += (v[j].x * v[j].x + v[j].y * v[j].y) + (v[j].z * v[j].z + v[j].w * v[j].w);
        ss = wave_sum(ss);
        const float rstd = 1.0f / sqrtf(ss * (1.0f / D) + EPS);
        if (FINAL) {
#pragma unroll
            for (int j = 0; j < 4; ++j) *(f32x4*)(F.out + (size_t)m * D + 4 * F.lane + 256 * j) = v[j] * rstd * g[j];
        } else {
#pragma unroll
            for (int j = 0; j < 4; ++j) {
                *(f32x4*)(F.out + (size_t)m * D + 4 * F.lane + 256 * j) = v[j];
                const f32x4 hh = v[j] * rstd * g[j]; u32x2 o; o.x = pk2(hh.x, hh.y); o.y = pk2(hh.z, hh.w);
                *(u32x2*)(F_H(F) + (size_t)m * D + 4 * F.lane + 256 * j) = o;
            }
        }
    }
}

typedef f32x4 AccT[2][2][4][2];
DI void rope4(f32x4& v, const f32x4 t) { const float a = v.x * t.x - v.y * t.y, b = v.x * t.y + v.y * t.x, c = v.z * t.z - v.w * t.w, d = v.z * t.w + v.w * t.z; v = (f32x4){a, b, c, d}; }
DI void store8(bf16* p, const f32x4 v0, const f32x4 v1) { u32x4 w; w.x = pk2(v0.x, v0.y); w.y = pk2(v0.z, v0.w); w.z = pk2(v1.x, v1.y); w.w = pk2(v1.z, v1.w); *(u32x4*)p = w; }

struct EpiInproj {
    static constexpr bool PERM = true;
    bf16* O; const f32x4* cs64; const f32x4* cs32;
    DI bool keep(const Unit&) const { return false; }
    DI void operator()(AccT& acc, const Unit& u, int wr, int wc, int fr, int fq) const {
        const int row0 = u.pm * 256 + wr * 64 + fr;
#pragma unroll
        for (int bj = 0; bj < 2; ++bj) {
            const int cg = u.pn * 256 + bj * 128 + wc * 32;
            int mode = 0;
            if (cg >= PJ_GATE) mode = 3;
            else if (cg >= PJ_DIL) { const int which = ((cg - PJ_DIL) % 768) >> 8; mode = which < 2 ? 1 : 0; }
            else if (cg == PJ_KR) mode = 2;
            const int col0 = cg + 8 * fq;
#pragma unroll
            for (int ai = 0; ai < 2; ++ai)
#pragma unroll
                for (int m = 0; m < 4; ++m) {
                    const int row = row0 + ai * 128 + m * 16;
                    f32x4 v0 = acc[ai][bj][m][0], v1 = acc[ai][bj][m][1];
                    if (mode == 1) { const f32x4* t = cs64 + (size_t)row * 16 + 8 * ((cg >> 5) & 1) + 2 * fq; rope4(v0, t[0]); rope4(v1, t[1]); }
                    else if (mode == 2) { const f32x4* t = cs32 + (size_t)row * 8 + 2 * fq; rope4(v0, t[0]); rope4(v1, t[1]); }
                    else if (mode == 3) {
#pragma unroll
                        for (int e = 0; e < 4; ++e) { v0[e] = fminf(1.0f + fexp2(-LOG2E * v0[e]), 1e30f); v1[e] = fminf(1.0f + fexp2(-LOG2E * v1[e]), 1e30f); }
                    }
                    store8(O + (size_t)row * NPROJ + col0, v0, v1);
                }
        }
    }
};

struct EpiMlaUp {
    static constexpr bool PERM = true;
    bf16* O; const bf16* P; const f32x4* cs32;
    DI bool keep(const Unit&) const { return false; }
    DI void operator()(AccT& acc, const Unit& u, int wr, int wc, int fr, int fq) const {
        const int row0 = u.pm * 256 + wr * 64 + fr;
        float rq[2][4], rkv[2][4];
#pragma unroll
        for (int ai = 0; ai < 2; ++ai)
#pragma unroll
            for (int m = 0; m < 4; ++m) {
                const bf16* pr = P + (size_t)(row0 + ai * 128 + m * 16) * NPROJ + PJ_MLA;
                float sq = 0.f, sk = 0.f;
#pragma unroll
                for (int i = 0; i < 8; ++i) { const u32x4 v = *(const u32x4*)(pr + 64 * fq + 8 * i);
#pragma unroll
                    for (int e = 0; e < 4; ++e) { const float a = bflo(v[e]), b = bfhi(v[e]); sq += a * a + b * b; } }
#pragma unroll
                for (int i = 0; i < 4; ++i) { const u32x4 v = *(const u32x4*)(pr + 256 + 32 * fq + 8 * i);
#pragma unroll
                    for (int e = 0; e < 4; ++e) { const float a = bflo(v[e]), b = bfhi(v[e]); sk += a * a + b * b; } }
                sq += __shfl_xor(sq, 16); sq += __shfl_xor(sq, 32); sk += __shfl_xor(sk, 16); sk += __shfl_xor(sk, 32);
                rq[ai][m] = C_MLA / sqrtf(sq * (1.0f / 256.0f) + EPS); rkv[ai][m] = 1.0f / sqrtf(sk * (1.0f / 128.0f) + EPS);
            }
#pragma unroll
        for (int bj = 0; bj < 2; ++bj) {
            const int gidx = (u.pn * 256 + bj * 128 + wc * 32) >> 5; const bool isq = gidx < 12, rope = isq && (gidx % 3 == 2);
            const int col0 = gidx * 32 + 8 * fq;
#pragma unroll
            for (int ai = 0; ai < 2; ++ai)
#pragma unroll
                for (int m = 0; m < 4; ++m) {
                    const int row = row0 + ai * 128 + m * 16; float sca = rq[ai][m], scb = rkv[ai][m]; asm volatile("" : "+v"(sca), "+v"(scb)); const float sc = isq ? sca : scb;
                    f32x4 v0 = acc[ai][bj][m][0] * sc, v1 = acc[ai][bj][m][1] * sc;
                    if (rope) { const f32x4* t = cs32 + (size_t)row * 8 + 2 * fq; rope4(v0, t[0]); rope4(v1, t[1]); }
                    store8(O + (size_t)row * D + col0, v0, v1);
                }
        }
    }
};

struct EpiMerge {
    static constexpr bool PERM = true;
    bf16* O; const bf16* P;
    DI bool keep(const Unit& u) const { return (u.pn >> 2) < 2; }
    DI void operator()(AccT& acc, const Unit& u, int wr, int wc, int fr, int fq) const {
        const int row0 = u.pm * 256 + wr * 64 + fr, n = u.pn >> 2, jt = u.pn & 3;
#pragma unroll
        for (int bj = 0; bj < 2; ++bj) {
            const int col0 = jt * 256 + bj * 128 + wc * 32 + 8 * fq;
#pragma unroll
            for (int ai = 0; ai < 2; ++ai)
#pragma unroll
                for (int m = 0; m < 4; ++m) {
                    const int row = row0 + ai * 128 + m * 16;
                    const bf16* gp = P + (size_t)row * NPROJ + PJ_GATE + col0;
                    const u32x4 da = *(const u32x4*)(gp + n * 1024);
                    f32x4 f0, f1;
                    f0.x = frcp(bflo(da.x)); f0.y = frcp(bfhi(da.x)); f0.z = frcp(bflo(da.y)); f0.w = frcp(bfhi(da.y));
                    f1.x = frcp(bflo(da.z)); f1.y = frcp(bfhi(da.z)); f1.z = frcp(bflo(da.w)); f1.w = frcp(bfhi(da.w));
                    if (n < 2) {
                        const u32x4 db = *(const u32x4*)(gp + (n + 1) * 1024);
                        f0.x *= bflo(db.x); f0.y *= bfhi(db.x); f0.z *= bflo(db.y); f0.w *= bfhi(db.y);
                        f1.x *= bflo(db.z); f1.y *= bfhi(db.z); f1.z *= bflo(db.w); f1.w *= bfhi(db.w);
                        acc[ai][bj][m][0] *= f0; acc[ai][bj][m][1] *= f1;
                    } else {
                        store8(O + (size_t)row * D + col0, acc[ai][bj][m][0] * f0, acc[ai][bj][m][1] * f1);
                    }
                }
        }
    }
};
struct MergeOrder { int G, c;
    DI bool next(int i, Unit& u) const { const int tile = c + (i / 3) * G; if (tile >= 256) return false; const int n = i % 3; u.pm = tile >> 2; u.pn = n * 4 + (tile & 3); u.ka = n * 256; return true; } };

struct EpiResid {
    static constexpr bool PERM = false;
    float* X;
    DI bool keep(const Unit&) const { return false; }
    DI void operator()(AccT& acc, const Unit& u, int wr, int wc, int fr, int fq) const {
        const int row0 = u.pm * 256 + wr * 64 + fr, colb = u.pn * 256 + wc * 32 + 4 * fq;
#pragma unroll
        for (int ai = 0; ai < 2; ++ai)
#pragma unroll
            for (int m = 0; m < 4; ++m) { float* rp = X + (size_t)(row0 + ai * 128 + m * 16) * D + colb;
#pragma unroll
                for (int bj = 0; bj < 2; ++bj)
#pragma unroll
                    for (int n = 0; n < 2; ++n) { f32x4* p = (f32x4*)(rp + bj * 128 + n * 16); *p = *p + acc[ai][bj][m][n]; } }
    }
};

struct EpiSwiglu {
    static constexpr bool PERM = true;
    bf16* O;
    DI bool keep(const Unit&) const { return false; }
    DI void operator()(AccT& acc, const Unit& u, int wr, int wc, int fr, int fq) const {
        const int row0 = u.pm * 256 + wr * 64 + fr, col0 = (u.pn & 1) * 128 + wc * 32 + 8 * fq;
#pragma unroll
        for (int ai = 0; ai < 2; ++ai)
#pragma unroll
            for (int m = 0; m < 4; ++m) {
                f32x4 r[2];
#pragma unroll
                for (int n = 0; n < 2; ++n) { const f32x4 gt = acc[ai][0][m][n], up = acc[ai][1][m][n];
#pragma unroll
                    for (int e = 0; e < 4; ++e) r[n][e] = gt[e] * up[e] * frcp(1.0f + fexp2(-LOG2E * gt[e])); }
                store8(O + (size_t)(row0 + ai * 128 + m * 16) * 256 + col0, r[0], r[1]);
            }
    }
};
struct EpiY {
    static constexpr bool PERM = true;
    bf16* O;
    DI bool keep(const Unit&) const { return false; }
    DI void operator()(AccT& acc, const Unit& u, int wr, int wc, int fr, int fq) const {
        const int row0 = u.pm * 256 + wr * 64 + fr;
#pragma unroll
        for (int bj = 0; bj < 2; ++bj) { const int col0 = (u.pn & 3) * 256 + bj * 128 + wc * 32 + 8 * fq;
#pragma unroll
            for (int ai = 0; ai < 2; ++ai)
#pragma unroll
                for (int m = 0; m < 4; ++m) store8(O + (size_t)(row0 + ai * 128 + m * 16) * D + col0, acc[ai][bj][m][0], acc[ai][bj][m][1]); }
    }
};
struct MoeOrder { const LAS int* ts; int nN, G, c;
    DI bool next(int i, Unit& u) const {
        const int L = i * G + c; const int ntile = __builtin_amdgcn_readfirstlane(ts[16]); if (L >= ntile * nN) return false;
        const int pm = L / nN, j = L - pm * nN; int e = 0;
#pragma unroll
        for (int k = 1; k < 16; ++k) e += (pm >= ts[k]) ? 1 : 0;
        e = __builtin_amdgcn_readfirstlane(e);
        u.pm = pm; u.pn = e * nN + j; u.ka = 0; return true; } };

DI void route_phase(Frame& F, int l) {
    LAS float* Wr = (LAS float*)F.lds;
    LAS int* eid = (LAS int*)(F.lds + 98304);
    const float* wg = F_w_gr(F) + (size_t)l * 1024 * 4; const float* we = F_w_er(F) + (size_t)l * 1024 * 16;
    for (int i = F.tid; i < 4096; i += 512) Wr[(i & 3) * 1024 + (i >> 2)] = wg[i];
    for (int i = F.tid; i < 16384; i += 512) Wr[(4 + (i & 15)) * 1024 + (i >> 4)] = we[i];
    __syncthreads();
    const int tok0 = F.bx * 64 + F.wave * 8;
    f32x4 xv[8][4], g[4];
#pragma unroll
    for (int j = 0; j < 4; ++j) g[j] = *(const f32x4*)(F_g_ffn(F) + l * 1024 + 4 * F.lane + 256 * j);
#pragma unroll
    for (int i = 0; i < 8; ++i)
#pragma unroll
        for (int j = 0; j < 4; ++j) xv[i][j] = *(const f32x4*)(F.out + (size_t)(tok0 + i) * D + 4 * F.lane + 256 * j);
#pragma unroll
    for (int i = 0; i < 8; ++i) {
        float ss = 0.f;
#pragma unroll
        for (int j = 0; j < 4; ++j) ss += (xv[i][j].x * xv[i][j].x + xv[i][j].y * xv[i][j].y) + (xv[i][j].z * xv[i][j].z + xv[i][j].w * xv[i][j].w);
        ss = wave_sum(ss);
        const float rstd = 1.0f / sqrtf(ss * (1.0f / D) + EPS);
#pragma unroll
        for (int j = 0; j < 4; ++j) { xv[i][j] = xv[i][j] * rstd * g[j]; u32x2 o; o.x = pk2(xv[i][j].x, xv[i][j].y); o.y = pk2(xv[i][j].z, xv[i][j].w);
            *(u32x2*)(F_H(F) + (size_t)(tok0 + i) * D + 4 * F.lane + 256 * j) = o; }
    }
    LAS float* lgs = (LAS float*)(F.lds + 100352) + F.wave * 160;
#pragma unroll 1
    for (int c = 0; c < 20; ++c) {
        f32x4 w[4];
#pragma unroll
        for (int j = 0; j < 4; ++j) w[j] = *(const LAS f32x4*)(Wr + c * 1024 + 4 * F.lane + 256 * j);
#pragma unroll
        for (int i = 0; i < 8; ++i) {
            float p = 0.f;
#pragma unroll
            for (int j = 0; j < 4; ++j) p += (xv[i][j].x * w[j].x + xv[i][j].y * w[j].y) + (xv[i][j].z * w[j].z + xv[i][j].w * w[j].w);
            p = wave_sum(p);
            if (F.lane == 0) lgs[i * 20 + c] = p;
        }
    }
    LDS_WAIT();
    float lg[20];
#pragma unroll
    for (int c = 0; c < 20; ++c) lg[c] = lgs[(F.lane & 7) * 20 + c];
    {
        float gl[4], el[16];
#pragma unroll
        for (int c = 0; c < 4; ++c) gl[c] = lg[c] + F_b_gr(F)[l * 4 + c];
#pragma unroll
        for (int c = 0; c < 16; ++c) el[c] = lg[4 + c] + F_b_er(F)[l * 16 + c];
        int gsel = 0; float best = gl[0];
#pragma unroll
        for (int c = 1; c < 4; ++c) if (gl[c] > best) { best = gl[c]; gsel = c; }
        float den = 0.f;
#pragma unroll
        for (int c = 0; c < 4; ++c) den += expf(gl[c] - best);
        const float pg = 1.0f / den;
        float ig[4];
#pragma unroll
        for (int e = 0; e < 4; ++e) ig[e] = gsel == 0 ? el[e] : gsel == 1 ? el[4 + e] : gsel == 2 ? el[8 + e] : el[12 + e];
        int ia = 0; float va = ig[0];
#pragma unroll
        for (int e = 1; e < 4; ++e) if (ig[e] > va) { va = ig[e]; ia = e; }
        int ib = -1; float vb = -INFINITY;
#pragma unroll
        for (int e = 0; e < 4; ++e) if (e != ia && ig[e] > vb) { vb = ig[e]; ib = e; }
        if (ib < 0) ib = (ia + 1) & 3;
        const float pa = 1.0f / (1.0f + expf(vb - va)), pb = 1.0f - pa;
        if (F.lane < 8) {
            const int t = tok0 + F.lane, e0 = 4 * gsel + ia, e1 = 4 * gsel + ib;
            F_tok_e(F)[2 * t] = e0; F_tok_e(F)[2 * t + 1] = e1; F_tok_w(F)[2 * t] = pg * pa; F_tok_w(F)[2 * t + 1] = pg * pb;
            eid[(F.wave * 8 + F.lane) * 2] = e0; eid[(F.wave * 8 + F.lane) * 2 + 1] = e1;
        }
    }
    __syncthreads();
    if (F.wave == 0) {
        const int e0 = eid[2 * F.lane], e1 = eid[2 * F.lane + 1];
        const unsigned long long lt = (1ull << F.lane) - 1ull;
        int r0 = 0, r1 = 0, cnt = 0;
#pragma unroll
        for (int ee = 0; ee < 16; ++ee) {
            const unsigned long long m0 = __ballot(e0 == ee), m1 = __ballot(e1 == ee);
            const int c0 = __popcll(m0);
            if (e0 == ee) r0 = __popcll(m0 & lt);
            if (e1 == ee) r1 = c0 + __popcll(m1 & lt);
            if (F.lane == ee) cnt = c0 + __popcll(m1);
        }
        const int t = F.bx * 64 + F.lane;
        F_tok_rank(F)[2 * t] = r0; F_tok_rank(F)[2 * t + 1] = r1;
        if (F.lane < 16) F_blk_cnt(F)[F.bx * 16 + F.lane] = cnt;
    }
}

DI void moe_tables(Frame& F) {
    LAS int* ctl = (LAS int*)(F.lds + LDSCTL_OFF);
    if (F.tid < 16) {
        int tot = 0, base = 0;
        for (int b = 0; b < F.G; ++b) { const int c = F_blk_cnt(F)[b * 16 + F.tid]; tot += c; if (b < F.bx) base += c; }
        ctl[LC_TOT / 4 + F.tid] = tot; ctl[LC_BASE / 4 + F.tid] = base;
    }
    __syncthreads();
    if (F.tid == 0) { int acc = 0; for (int e = 0; e < 16; ++e) { ctl[LC_SEG / 4 + e] = acc * 256; ctl[LC_TS / 4 + e] = acc; acc += (ctl[LC_TOT / 4 + e] + 255) >> 8; } ctl[LC_TS / 4 + 16] = acc; }
    __syncthreads();
}

DI void perm_phase(Frame& F) {
    moe_tables(F);
    const LAS int* ctl = (const LAS int*)(F.lds + LDSCTL_OFF);
    for (int i = 0; i < 8; ++i) {
        const int t = F.bx * 64 + F.wave * 8 + i;
#pragma unroll
        for (int k = 0; k < 2; ++k) {
            const int e = F_tok_e(F)[2 * t + k], r = F_tok_rank(F)[2 * t + k];
            const int pos = ctl[LC_SEG / 4 + e] + ctl[LC_BASE / 4 + e] + r;
            if (F.lane == 0) F_tok_pos(F)[2 * t + k] = pos;
            const u32x4* s = (const u32x4*)(F_H(F) + (size_t)t * D); u32x4* d = (u32x4*)(F_HPERM(F) + (size_t)pos * D);
            d[F.lane] = s[F.lane]; d[F.lane + 64] = s[F.lane + 64];
        }
    }
}

#define MFMA32(a, b, c) __builtin_amdgcn_mfma_f32_32x32x16_bf16((a), (b), (c), 0, 0, 0)
DI int crow(int i, int h) { return (i & 3) + 8 * (i >> 2) + 4 * h; }
DI bf16x8 pack8(const f32x16& x, int s) { u32x4 p; p.x = pk2(x[8 * s], x[8 * s + 1]); p.y = pk2(x[8 * s + 2], x[8 * s + 3]); p.z = pk2(x[8 * s + 4], x[8 * s + 5]); p.w = pk2(x[8 * s + 6], x[8 * s + 7]); return __builtin_bit_cast(bf16x8, p); }
DI s16x4 tr_read(const LAS unsigned char* p) { return __builtin_bit_cast(s16x4, __builtin_amdgcn_ds_read_tr16_b64_v4i16((LAS v4i16_t*)p)); }
constexpr int VP = 144;
DI bf16x8 vfrag(const LAS unsigned char* vlane, int off) { const s16x4 lo = tr_read(vlane + off), hi = tr_read(vlane + off + 8 * VP); return __builtin_shufflevector(lo, hi, 0, 1, 2, 3, 4, 5, 6, 7); }
DI void pv_accum(f32x16 (&oT)[2], const LAS unsigned char* vlane, const bf16x8 (&pp)[2][2]) {
#pragma unroll
    for (int blk = 0; blk < 2; ++blk)
#pragma unroll
        for (int s = 0; s < 2; ++s)
#pragma unroll
            for (int db = 0; db < 2; ++db) oT[db] = MFMA32(vfrag(vlane, (32 * blk + 16 * s) * VP + db * 64), pp[blk][s], oT[db]);
}
DI void softmax_tile(const f32x16& s0, const f32x16& s1, float& mrun, float& lrun, f32x16 (&oT)[2], bf16x8 (&pp)[2][2]) {
    float mx = fmaxf(s0[0], s1[0]);
#pragma unroll
    for (int i = 1; i < 16; ++i) mx = fmaxf(mx, fmaxf(s0[i], s1[i]));
    mx = fmaxf(mx, __shfl_xor(mx, 32));
    const float mnew = fmaxf(mrun, mx), alpha = fexp2(mrun - mnew);
    mrun = mnew;
    f32x16 p0, p1; float rs = 0.f;
#pragma unroll
    for (int i = 0; i < 16; ++i) { p0[i] = fexp2(s0[i] - mnew); p1[i] = fexp2(s1[i] - mnew); rs += p0[i] + p1[i]; }
    lrun = lrun * alpha + rs;
#pragma unroll
    for (int i = 0; i < 16; ++i) { oT[0][i] *= alpha; oT[1][i] *= alpha; }
    pp[0][0] = pack8(p0, 0); pp[0][1] = pack8(p0, 1); pp[1][0] = pack8(p1, 0); pp[1][1] = pack8(p1, 1);
}
DI void store_oT(bf16* orow, const f32x16 (&oT)[2], float sc, int h) {
#pragma unroll
    for (int db = 0; db < 2; ++db)
#pragma unroll
        for (int gq = 0; gq < 4; ++gq) { u32x2 w; w.x = pk2(oT[db][4 * gq] * sc, oT[db][4 * gq + 1] * sc); w.y = pk2(oT[db][4 * gq + 2] * sc, oT[db][4 * gq + 3] * sc);
            *(u32x2*)(orow + 32 * db + 8 * gq + 4 * h) = w; }
}

constexpr int SB_KP = 144, SB_TILE = 64 * SB_KP, SB_BUF = 2 * SB_TILE;
DI void sb_unit(Frame& F, int b, int hd, int qb) {
    const int lane = F.lane, r32 = lane & 31, h = lane >> 5, wave = F.wave;
    const int q0w = qb * 256 + wave * 32, qpos = q0w + r32;
    const size_t rowbase = (size_t)b * SEQ;
    const bf16* P = F_PROJ(F);
    bf16x8 qf[4];
#pragma unroll
    for (int s = 0; s < 4; ++s) qf[s] = *(const bf16x8*)(P + (rowbase + qpos) * NPROJ + PJ_SB + hd * 64 + 16 * s + 8 * h);
    bf16x8 tri[2], ones;
#pragma unroll
    for (int s = 0; s < 2; ++s)
#pragma unroll
        for (int j = 0; j < 8; ++j) tri[s][j] = ((16 * s + 8 * (j >> 2) + 4 * h + (j & 3)) > r32) ? (short)0x3F80 : (short)0;
#pragma unroll
    for (int j = 0; j < 8; ++j) ones[j] = (short)0x3F80;
    f32x16 oT[2], carry;
#pragma unroll
    for (int i = 0; i < 16; ++i) { oT[0][i] = 0.f; oT[1][i] = 0.f; carry[i] = 0.f; }
    const int NT = 4 * (qb + 1);
    const int srow = F.tid >> 3, sch = F.tid & 7;
    const bf16* kg = P + (rowbase + srow) * NPROJ + PJ_SB + 256 + hd * 64 + sch * 8;
    u32x4 kreg = *(const u32x4*)(kg + (size_t)(NT - 1) * 64 * NPROJ), vreg = *(const u32x4*)(kg + (size_t)(NT - 1) * 64 * NPROJ + 256);
    const int ldst = srow * SB_KP + sch * 16;
    const int klane = r32 * SB_KP + 16 * h;
    const int vlane_off = (4 * h + ((lane & 15) >> 2)) * VP + ((lane >> 4) & 1) * 32 + (lane & 3) * 8;
    for (int it = 0; it < NT; ++it) {
        const int kt = NT - 1 - it;
        LAS unsigned char* Kb = F.lds + (it & 1) * SB_BUF; LAS unsigned char* Vb = Kb + SB_TILE;
        *(LAS u32x4*)(Kb + ldst) = kreg; *(LAS u32x4*)(Vb + ldst) = vreg;
        __syncthreads();
        if (it + 1 < NT) { kreg = *(const u32x4*)(kg + (size_t)(kt - 1) * 64 * NPROJ); vreg = *(const u32x4*)(kg + (size_t)(kt - 1) * 64 * NPROJ + 256); }
        if (kt * 64 < q0w + 31) {
            f32x16 st0, st1;
#pragma unroll
            for (int i = 0; i < 16; ++i) { st0[i] = 0.f; st1[i] = 0.f; }
#pragma unroll
            for (int s = 0; s < 4; ++s) {
                const bf16x8 k0 = *(const LAS bf16x8*)(Kb + klane + 32 * s), k1 = *(const LAS bf16x8*)(Kb + klane + 32 * SB_KP + 32 * s);
                st0 = MFMA32(k0, qf[s], st0); st1 = MFMA32(k1, qf[s], st1);
            }
            f32x16 sp0, sp1;
            const int kb0 = kt * 64 + 4 * h;
#pragma unroll
            for (int i = 0; i < 16; ++i) {
                const int key0 = kb0 + (i & 3) + 8 * (i >> 2);
                st0[i] = fminf(st0[i], 126.f); st1[i] = fminf(st1[i], 126.f);
                const float a0 = flog2(1.0f + fexp2(st0[i])), a1 = flog2(1.0f + fexp2(st1[i]));
                sp0[i] = (key0 < qpos) ? a0 : 0.f; sp1[i] = (key0 + 32 < qpos) ? a1 : 0.f;
            }
            const bf16x8 s00 = pack8(sp0, 0), s01 = pack8(sp0, 1), s10 = pack8(sp1, 0), s11 = pack8(sp1, 1);
            f32x16 t1 = MFMA32(ones, s10, carry); t1 = MFMA32(ones, s11, t1);
            f32x16 y1 = MFMA32(tri[0], s10, carry); y1 = MFMA32(tri[1], s11, y1);
            f32x16 y0 = MFMA32(tri[0], s00, t1); y0 = MFMA32(tri[1], s01, y0);
            carry = MFMA32(ones, s00, t1); carry = MFMA32(ones, s01, carry);
            f32x16 w0, w1;
#pragma unroll
            for (int i = 0; i < 16; ++i) {
                const int key0 = kb0 + (i & 3) + 8 * (i >> 2);
                const float e0 = fexp2(st0[i] - sp0[i] - y0[i]), e1 = fexp2(st1[i] - sp1[i] - y1[i]);
                w0[i] = (key0 < qpos) ? e0 : 0.f; w1[i] = (key0 + 32 < qpos) ? e1 : 0.f;
            }
            bf16x8 pp[2][2]; pp[0][0] = pack8(w0, 0); pp[0][1] = pack8(w0, 1); pp[1][0] = pack8(w1, 0); pp[1][1] = pack8(w1, 1);
            pv_accum(oT, Vb + vlane_off, pp);
        }
    }
    store_oT(F_OBR(F) + (rowbase + qpos) * 768 + hd * 64, oT, 1.0f, h);
}

constexpr int ML_KP = 208, ML_KT = 64 * ML_KP, ML_BUF = ML_KT + 64 * VP;
DI void mla_unit(Frame& F, int b, int hd, int qb) {
    const int lane = F.lane, r32 = lane & 31, h = lane >> 5, wave = F.wave;
    const int q0w = qb * 256 + wave * 32, qpos = q0w + r32;
    const size_t rowbase = (size_t)b * SEQ;
    const bf16* MQp = F_MQ(F); const bf16* P = F_PROJ(F);
    bf16x8 qf[6];
#pragma unroll
    for (int s = 0; s < 6; ++s) qf[s] = *(const bf16x8*)(MQp + (rowbase + qpos) * D + hd * 96 + 16 * s + 8 * h);
    f32x16 oT[2];
#pragma unroll
    for (int i = 0; i < 16; ++i) { oT[0][i] = 0.f; oT[1][i] = 0.f; }
    float mrun = -1e30f, lrun = 0.f;
    const int NT = 4 * (qb + 1);
    const int i0 = F.tid, i1 = F.tid + 512;
    const int r0 = i0 / 12, c0 = i0 % 12, r1 = i1 / 12, c1 = i1 % 12; const bool has1 = i1 < 768;
    const bf16* kg0 = (c0 < 8) ? MQp + (rowbase + r0) * D + 384 + hd * 128 + c0 * 8 : P + (rowbase + r0) * NPROJ + PJ_KR + (c0 - 8) * 8;
    const size_t ks0 = (c0 < 8) ? (size_t)64 * D : (size_t)64 * NPROJ;
    const bf16* kg1 = (c1 < 8) ? MQp + (rowbase + (has1 ? r1 : 0)) * D + 384 + hd * 128 + c1 * 8 : P + (rowbase + (has1 ? r1 : 0)) * NPROJ + PJ_KR + (c1 - 8) * 8;
    const size_t ks1 = (c1 < 8) ? (size_t)64 * D : (size_t)64 * NPROJ;
    const int vr = F.tid >> 3, vc = F.tid & 7;
    const bf16* vg = MQp + (rowbase + vr) * D + 384 + hd * 128 + 64 + vc * 8;
    u32x4 kreg0 = *(const u32x4*)kg0, kreg1 = (u32x4){0u, 0u, 0u, 0u}, vreg = *(const u32x4*)vg;
    if (has1) kreg1 = *(const u32x4*)kg1;
    const int kd0 = r0 * ML_KP + c0 * 16, kd1 = r1 * ML_KP + c1 * 16, vd = vr * VP + vc * 16;
    const int klane = r32 * ML_KP + 16 * h;
    const int vlane_off = (4 * h + ((lane & 15) >> 2)) * VP + ((lane >> 4) & 1) * 32 + (lane & 3) * 8;
    for (int kt = 0; kt < NT; ++kt) {
        LAS unsigned char* Kb = F.lds + (kt & 1) * ML_BUF; LAS unsigned char* Vb = Kb + ML_KT;
        *(LAS u32x4*)(Kb + kd0) = kreg0; if (has1) *(LAS u32x4*)(Kb + kd1) = kreg1; *(LAS u32x4*)(Vb + vd) = vreg;
        __syncthreads();
        if (kt + 1 < NT) { kreg0 = *(const u32x4*)(kg0 + (size_t)(kt + 1) * ks0); if (has1) kreg1 = *(const u32x4*)(kg1 + (size_t)(kt + 1) * ks1); vreg = *(const u32x4*)(vg + (size_t)(kt + 1) * 64 * D); }
        if (kt * 64 <= q0w + 31) {
            f32x16 st0, st1;
#pragma unroll
            for (int i = 0; i < 16; ++i) { st0[i] = 0.f; st1[i] = 0.f; }
#pragma unroll
            for (int s = 0; s < 6; ++s) {
                const bf16x8 k0 = *(const LAS bf16x8*)(Kb + klane + 32 * s), k1 = *(const LAS bf16x8*)(Kb + klane + 32 * ML_KP + 32 * s);
                st0 = MFMA32(k0, qf[s], st0); st1 = MFMA32(k1, qf[s], st1);
            }
            if (kt * 64 + 63 > q0w) {
                const int kb0 = kt * 64 + 4 * h;
#pragma unroll
                for (int i = 0; i < 16; ++i) { const int key0 = kb0 + (i & 3) + 8 * (i >> 2); if (key0 > qpos) st0[i] = -INFINITY; if (key0 + 32 > qpos) st1[i] = -INFINITY; }
            }
            bf16x8 pp[2][2];
            softmax_tile(st0, st1, mrun, lrun, oT, pp);
            pv_accum(oT, Vb + vlane_off, pp);
        }
    }
    const float ltot = lrun + __shfl_xor(lrun, 32);
    store_oT(F_OBR(F) + (rowbase + qpos) * 768 + 256 + hd * 64, oT, 1.0f / ltot, h);
}

template <int GI>
DI void dil_group(Frame& F, int b, int hd, int P0, int r32, int h, int lane, LAS unsigned char* Vw, float& mrun, float& lrun, f32x16 (&oT)[2]) {
    constexpr int SH = GI == 0 ? 0 : (GI == 1 ? 2 : 4), R = 1 << SH, STEP = 16 >> SH, NTILE = GI == 0 ? 10 : (GI == 1 ? 4 : 3), NSUB = SEQ >> SH;
    const bf16* P = F_PROJ(F);
    const size_t rowbase = (size_t)b * SEQ;
    const int rc = P0 & (R - 1), i0 = P0 >> SH, iq = i0 + STEP * r32, start = i0 - 128;
    const int qcol = PJ_DIL + GI * 768 + hd * 64, kcol = qcol + 256, vcol = qcol + 512;
    bf16x8 qf[4];
#pragma unroll
    for (int s = 0; s < 4; ++s) qf[s] = *(const bf16x8*)(P + (rowbase + P0 + 16 * r32) * NPROJ + qcol + 16 * s + 8 * h);
    const int vlane_off = (4 * h + ((lane & 15) >> 2)) * VP + ((lane >> 4) & 1) * 32 + (lane & 3) * 8;
    for (int kt = 0; kt < NTILE; ++kt) {
        const int kidx0 = start + 64 * kt;
        bf16x8 kf[2][4];
#pragma unroll
        for (int blk = 0; blk < 2; ++blk) {
            int kid = kidx0 + 32 * blk + r32; kid = kid < 0 ? 0 : (kid > NSUB - 1 ? NSUB - 1 : kid);
            const bf16* kp = P + (rowbase + rc + ((size_t)kid << SH)) * NPROJ + kcol + 8 * h;
#pragma unroll
            for (int s = 0; s < 4; ++s) kf[blk][s] = *(const bf16x8*)(kp + 16 * s);
        }
        u32x4 vv[8];
#pragma unroll
        for (int i = 0; i < 8; ++i) {
            int kid = kidx0 + (lane >> 3) + 8 * i; kid = kid < 0 ? 0 : (kid > NSUB - 1 ? NSUB - 1 : kid);
            vv[i] = *(const u32x4*)(P + (rowbase + rc + ((size_t)kid << SH)) * NPROJ + vcol + (lane & 7) * 8);
        }
        asm volatile("" ::: "memory");
#pragma unroll
        for (int i = 0; i < 8; ++i) *(LAS u32x4*)(Vw + ((lane >> 3) + 8 * i) * VP + (lane & 7) * 16) = vv[i];
        LDS_WAIT();
        f32x16 st0, st1;
#pragma unroll
        for (int i = 0; i < 16; ++i) { st0[i] = 0.f; st1[i] = 0.f; }
#pragma unroll
        for (int s = 0; s < 4; ++s) { st0 = MFMA32(kf[0][s], qf[s], st0); st1 = MFMA32(kf[1][s], qf[s], st1); }
#pragma unroll
        for (int i = 0; i < 16; ++i) {
            const int k0 = kidx0 + 4 * h + (i & 3) + 8 * (i >> 2), k1 = k0 + 32;
            if (!(k0 >= 0 && k0 <= iq && k0 >= iq - 128)) st0[i] = -INFINITY;
            if (!(k1 >= 0 && k1 <= iq && k1 >= iq - 128)) st1[i] = -INFINITY;
        }
        bf16x8 pp[2][2];
        softmax_tile(st0, st1, mrun, lrun, oT, pp);
        pv_accum(oT, Vw + vlane_off, pp);
        LDS_WAIT();
    }
}
DI void dil_unit(Frame& F, int b, int hd, int span, int half) {
    const int lane = F.lane, r32 = lane & 31, h = lane >> 5;
    const int P0 = span * 512 + 8 * half + F.wave;
    LAS unsigned char* Vw = F.lds + F.wave * (64 * VP);
    f32x16 oT[2];
#pragma unroll
    for (int i = 0; i < 16; ++i) { oT[0][i] = 0.f; oT[1][i] = 0.f; }
    float mrun = -1e30f, lrun = 0.f;
    dil_group<0>(F, b, hd, P0, r32, h, lane, Vw, mrun, lrun, oT);
    dil_group<1>(F, b, hd, P0, r32, h, lane, Vw, mrun, lrun, oT);
    dil_group<2>(F, b, hd, P0, r32, h, lane, Vw, mrun, lrun, oT);
    const float ltot = lrun + __shfl_xor(lrun, 32);
    store_oT(F_OBR(F) + ((size_t)b * SEQ + P0 + 16 * r32) * 768 + 512 + hd * 64, oT, 1.0f / ltot, h);
}

DI void attn_phase(Frame& F, int l) {
    unsigned* ctr = F_ctl(F) + CW_Q + 64 * l;
    volatile LAS unsigned* slot = (volatile LAS unsigned*)(F.lds + LDSCTL_OFF + LC_Q);
    constexpr unsigned NU = 768;
    for (;;) {
        if (F.tid == 0) *slot = __hip_atomic_fetch_add(ctr, 1u, __ATOMIC_RELAXED, __HIP_MEMORY_SCOPE_AGENT);
        __syncthreads();
        const unsigned u = (unsigned)__builtin_amdgcn_readfirstlane((int)*slot);
        __syncthreads();
        if (u >= NU) break;
        if (u < 512u) {
            const int qb = 31 - (int)(u >> 4), r = (int)(u & 15u), bh = r & 7, b = bh >> 2, hd = bh & 3;
            if (r < 8) sb_unit(F, b, hd, qb); else mla_unit(F, b, hd, qb);
        } else {
            const int j = (int)u - 512; dil_unit(F, j >> 7, (j >> 5) & 3, (j & 31) >> 1, j & 1);
        }
    }
}

constexpr int N_PHASES = 41;

__global__ void __launch_bounds__(512, 2) fwd_kernel(Args a) {
    extern __shared__ __attribute__((aligned(16))) unsigned char lds_raw[];
    {
        LAS unsigned* lc = (LAS unsigned*)((LAS unsigned char*)lds_raw + LDSCTL_OFF);
        for (int u = threadIdx.x; u < (LDS_BYTES - LDSCTL_OFF) / 4; u += 512) lc[u] = 0u;
    }
    __syncthreads();
    const int lo = a.ph_lo, hi = a.ph_hi;
    unsigned* const barw = (unsigned*)(a.ws + WS_CTL) + CW_BAR;
    XcdBarrier bar; bar.bar = barw; bar.x = 0; bar.st = nullptr;
    if (hi - lo > 1) bar = xcd_barrier_post(barw, (volatile LAS unsigned*)((LAS unsigned char*)lds_raw + LDSCTL_OFF + LC_XB));
#define IN(k) (lo <= (k) && (k) < hi)
#define SEAM(k) do { if (IN(k) && IN((k) + 1)) xcd_barrier(bar); } while (0)

    for (int l = 0; l < NLAYER; ++l) {
        const int pb = 10 * l;
        if (IN(pb + 0)) { Frame F = mkframe(); if (l == 0) pre_tables(F); conv_phase(F, l); norm_phase<false>(F, l, F_g_mix(F) + l * 1024); }
        SEAM(pb + 0);
        if (IN(pb + 1)) {
            Frame F = mkframe();
            pg8::Gemm g{F_H(F), F_Win_t(F), 1024, 1024, 1024}; pg8::StaticOrder S; S.init(T, NPROJ, F.G, F.bx);
            EpiInproj E{F_PROJ(F), (const f32x4*)F_cs64(F), (const f32x4*)F_cs32(F)};
            pg8::gemm_phase<EpiInproj, pg8::StaticOrder, true>(F.lds, F.tid, g, S, E);
        }
        SEAM(pb + 1);
        if (IN(pb + 2)) {
            Frame F = mkframe();
            pg8::Gemm g{F_PROJ(F) + PJ_MLA, F_Wup_t(F), NPROJ, 512, 512}; pg8::StaticOrder S; S.init(T, 1024, F.G, F.bx);
            EpiMlaUp E{F_MQ(F), F_PROJ(F), (const f32x4*)F_cs32(F)};
            pg8::gemm_phase<EpiMlaUp, pg8::StaticOrder, false>(F.lds, F.tid, g, S, E);
        }
        SEAM(pb + 2);
        if (IN(pb + 3)) { Frame F = mkframe(); attn_phase(F, l); }
        SEAM(pb + 3);
        if (IN(pb + 4)) {
            Frame F = mkframe();
            pg8::Gemm g{F_OBR(F), F_Wb_t(F), 768, 256, 256}; MergeOrder S{F.G, F.vcu};
            EpiMerge E{F_H(F), F_PROJ(F)};
            pg8::gemm_phase<EpiMerge, MergeOrder, false>(F.lds, F.tid, g, S, E);
        }
        SEAM(pb + 4);
        if (IN(pb + 5)) {
            Frame F = mkframe();
            pg8::Gemm g{F_H(F), F_Wout_t(F), 1024, 1024, 1024}; pg8::StaticOrder S; S.init(T, 1024, F.G, F.bx);
            EpiResid E{F.out};
            pg8::gemm_phase<EpiResid, pg8::StaticOrder, false>(F.lds, F.tid, g, S, E);
        }
        SEAM(pb + 5);
        if (IN(pb + 6)) { Frame F = mkframe(); route_phase(F, l); }
        SEAM(pb + 6);
        if (IN(pb + 7)) { Frame F = mkframe(); perm_phase(F); }
        SEAM(pb + 7);
        if (IN(pb + 8)) {
            Frame F = mkframe();
            moe_tables(F);
            pg8::Gemm g{F_HPERM(F), F_W1_t(F), 1024, 1024, 1024}; MoeOrder S{(const LAS int*)(F.lds + LDSCTL_OFF + LC_TS), 2, F.G, F.vcu};
            EpiSwiglu E{F_HID(F)};
            pg8::gemm_phase<EpiSwiglu, MoeOrder, true>(F.lds, F.tid, g, S, E);
        }
        SEAM(pb + 8);
        if (IN(pb + 9)) {
            Frame F = mkframe();
            moe_tables(F);
            pg8::Gemm g{F_HID(F), F_W2_t(F), 256, 256, 256}; MoeOrder S{(const LAS int*)(F.lds + LDSCTL_OFF + LC_TS), 4, F.G, F.vcu};
            EpiY E{F_YBUF(F)};
            pg8::gemm_phase<EpiY, MoeOrder, true>(F.lds, F.tid, g, S, E);
        }
        SEAM(pb + 9);
    }
    if (IN(40)) { Frame F = mkframe(); norm_phase<true>(F, NLAYER, F_g_final(F)); }
#undef IN
#undef SEAM
}

extern "C" void kernel_launch(void* const* d_in, const int* in_sizes, int n_in, void* d_out, int out_size, void* d_ws, size_t ws_size, hipStream_t stream) {
    static int grid = 0;
    if (grid == 0) {
        if (n_in != 19 || out_size != T * D || ws_size < WS_END) { fprintf(stderr, "kernel_launch: unexpected problem (n_in %d, out %d, ws %zu < %zu)\n", n_in, out_size, ws_size, (size_t)WS_END); grid = -1; return; }
        if (hipFuncSetAttribute((const void*)fwd_kernel, hipFuncAttributeMaxDynamicSharedMemorySize, LDS_BYTES) != hipSuccess) { fprintf(stderr, "kernel_launch: hipFuncSetAttribute failed\n"); grid = -1; return; }
        int per_cu = 0;
        if (hipOccupancyMaxActiveBlocksPerMultiprocessor(&per_cu, (const void*)fwd_kernel, 512, LDS_BYTES) != hipSuccess || per_cu < 1) fprintf(stderr, "kernel_launch: occupancy query reports %d blocks per CU\n", per_cu);
        (void)hipGetLastError();
        grid = 256;
    }
    if (grid < 0) return;
    (void)in_sizes;
    if (hipMemsetAsync((char*)d_ws + WS_CTL, 0, CTL_ZERO_BYTES, stream) != hipSuccess) return;
    Args a{};
    for (int i = 0; i < 19; ++i) a.in[i] = d_in[i];
    a.out = (float*)d_out; a.ws = (unsigned char*)d_ws;
#if MK_PER_PHASE
    for (int p = 0; p < N_PHASES; ++p) { a.ph_lo = p; a.ph_hi = p + 1; hipLaunchKernelGGL(fwd_kernel, dim3(grid), dim3(512), LDS_BYTES, stream, a); }
#else
    a.ph_lo = 0; a.ph_hi = N_PHASES;
    hipLaunchKernelGGL(fwd_kernel, dim3(grid), dim3(512), LDS_BYTES, stream, a);
#endif
}
```

```cpp
#include <hip/hip_runtime.h>
#include <cstdio>
#include <cstdint>

#ifndef MK_PER_PHASE
#define MK_PER_PHASE 0
#endif

#define LAS __attribute__((address_space(3)))
#define GAS __attribute__((address_space(1)))
typedef unsigned short bf16;
typedef short bf16x8 __attribute__((ext_vector_type(8)));
typedef short s16x4 __attribute__((ext_vector_type(4)));
typedef float f32x2 __attribute__((ext_vector_type(2)));
typedef float f32x4 __attribute__((ext_vector_type(4)));
typedef float f32x16 __attribute__((ext_vector_type(16)));
typedef unsigned u32x2 __attribute__((ext_vector_type(2)));
typedef unsigned u32x4 __attribute__((ext_vector_type(4)));
typedef __bf16 bf2_t __attribute__((ext_vector_type(2)));
typedef short v4i16_t __attribute__((ext_vector_type(4)));

#define DI __device__ __forceinline__
DI unsigned pk2(float a, float b) { f32x2 v = {a, b}; return __builtin_bit_cast(unsigned, __builtin_convertvector(v, bf2_t)); }
DI float bflo(unsigned u) { return __uint_as_float(u << 16); }
DI float bfhi(unsigned u) { return __uint_as_float(u & 0xffff0000u); }
DI float fexp2(float x) { return __builtin_amdgcn_exp2f(x); }
DI float flog2(float x) { return __builtin_amdgcn_logf(x); }
DI float frcp(float x) { return __builtin_amdgcn_rcpf(x); }

constexpr int T = 16384, D = 1024, SEQ = 8192, NLAYER = 4;
constexpr int NPROJ = 6656;
constexpr int PJ_SB = 0, PJ_MLA = 768, PJ_KR = 1152, PJ_DIL = 1280, PJ_GATE = 3584;
constexpr int INC = 6560;
constexpr float EPS = 1e-6f;
constexpr float LOG2E = 1.4426950408889634f;
constexpr float C_SB = 0.125f * LOG2E;
constexpr float C_MLA = 0.10206207261596577f * LOG2E;
constexpr int MROWS = 36864;

namespace pg8 {
constexpr int BM = 256, BK = 64, HALF = 128, HTB = HALF * BK * 2, STAGE_BYTES = 8 * HTB, NXCD = 8, WGM = 8;
__host__ __device__ __forceinline__ int lds_byte(int r, int c) { const int st = (r >> 4) * 2 + (c >> 5), rr = r & 15, cc = c & 31, ob = rr * 64 + cc * 2; return st * 1024 + (ob ^ (((ob >> 9) & 1) << 5)); }
__host__ __device__ __forceinline__ void stage_rc(int b, int& R, int& C) { const int st = b / 1024, sb = b % 1024, swz = sb ^ (((sb >> 9) & 1) << 5); R = (st >> 1) * 16 + swz / 64; C = (st & 1) * 32 + (swz % 64) / 2; }
__host__ __device__ __forceinline__ int perm32(int rho) { const int n = rho >> 4, i = rho & 15; return 8 * (i >> 2) + 4 * n + (i & 3); }

struct Unit { int pm, pn, ka; };
struct Gemm { const bf16* A; const bf16* Bt; int lda, ldb, K; };

struct StaticOrder {
    int nM, nN, nwg, G, c;
    __device__ void init(int M, int N, int G_, int c_) { nM = M / BM; nN = N / BM; nwg = nM * nN; G = G_; c = c_; }
    __device__ bool next(int i, Unit& u) const {
        const long L = (long)i * G + c; if (L >= nwg) return false;
        int wgid = (int)L; { const int q = nwg / NXCD, r = nwg % NXCD, xcd = wgid % NXCD, off = wgid / NXCD; wgid = (xcd < r ? xcd * (q + 1) : r * (q + 1) + (xcd - r) * q) + off; }
        const int nig = WGM * nN, gid = wgid / nig, fm = gid * WGM, gsz = (nM - fm) < WGM ? (nM - fm) : WGM;
        u.pm = fm + ((wgid % nig) % gsz); u.pn = (wgid % nig) / gsz; u.ka = 0; return true;
    }
};

template <class Epi, class Sched, bool ALIGN_EPI>
__device__ __forceinline__ void gemm_phase(LAS unsigned char* lds, const int tid, const Gemm g, const Sched& S, const Epi& E) {
    const int wid = __builtin_amdgcn_readfirstlane(tid >> 6), lane = tid & 63, wr = wid >> 2, wc = wid & 3, fr = lane & 15, fq = lane >> 4;
    const int K = g.K, nt = K / BK;
    unsigned voffA[2], voffB[2];
#pragma unroll
    for (int i = 0; i < 2; ++i) { int R, C; stage_rc(tid * 16 + i * 8192, R, C); const int Rb = Epi::PERM ? ((R & ~31) + perm32(R & 31)) : R;
        voffA[i] = (unsigned)(R * g.lda + C) * 2u; voffB[i] = (unsigned)(Rb * g.ldb + C) * 2u; }
    const size_t kstep = (size_t)(BK * 2);
    const size_t hstepA = (size_t)HALF * g.lda * 2, hstepB = (size_t)HALF * g.ldb * 2;
    const size_t tstepA = 2 * hstepA, tstepB = 2 * hstepB;
    const unsigned ldsw = (unsigned)wid * 1024u;
    const int aoff = lds_byte(wr * 64 + fr, fq * 8), boff = lds_byte(wc * 32 + fr, fq * 8);
#define PG8_SA(b, h) (((b) * 2 + (h)) * HTB)
#define PG8_SB(b, h) ((4 + (b) * 2 + (h)) * HTB)
#define PG8_STAGE(bufoff, gbase, voff) do { _Pragma("unroll") for (int _i = 0; _i < 2; ++_i) \
        __builtin_amdgcn_global_load_lds((const unsigned*)((const char*)(gbase) + (voff)[_i]), (LAS unsigned*)(lds + (bufoff) + ldsw + _i * 8192), 16, 0, 0); } while (0)
#define PG8_LDA(dst, b, h) do { _Pragma("unroll") for (int m = 0; m < 4; ++m) _Pragma("unroll") for (int k = 0; k < 2; ++k) dst[m][k] = *(const LAS bf16x8*)(lds + PG8_SA(b, h) + aoff + m * 2048 + k * 1024); } while (0)
#define PG8_LDB(dst, b, h) do { _Pragma("unroll") for (int n = 0; n < 2; ++n) _Pragma("unroll") for (int k = 0; k < 2; ++k) dst[n][k] = *(const LAS bf16x8*)(lds + PG8_SB(b, h) + boff + n * 2048 + k * 1024); } while (0)
#define PG8_MMA(ai, bj, At, Bt) do { __builtin_amdgcn_s_setprio(1); _Pragma("unroll") for (int m = 0; m < 4; ++m) _Pragma("unroll") for (int n = 0; n < 2; ++n) _Pragma("unroll") for (int k = 0; k < 2; ++k) \
        acc[ai][bj][m][n] = __builtin_amdgcn_mfma_f32_16x16x32_bf16(Bt[n][k], At[m][k], acc[ai][bj][m][n], 0, 0, 0); __builtin_amdgcn_s_setprio(0); } while (0)
#define PG8_WAIT_V(n) asm volatile("s_waitcnt vmcnt(" #n ")" ::: "memory")
#define PG8_WAIT_L(n) asm volatile("s_waitcnt lgkmcnt(" #n ")" ::: "memory")
#define PG8_BAR __builtin_amdgcn_s_barrier()
#define PG8_SCHED __builtin_amdgcn_sched_barrier(0)
    Unit cur, nxt; int ui = 0;
    if (!S.next(0, cur)) return;
    f32x4 acc[2][2][4][2];
#pragma unroll
    for (int a = 0; a < 2; ++a)
#pragma unroll
        for (int b = 0; b < 2; ++b)
#pragma unroll
            for (int m = 0; m < 4; ++m)
#pragma unroll
                for (int n = 0; n < 2; ++n) acc[a][b][m][n] = (f32x4){0.f, 0.f, 0.f, 0.f};
    bf16x8 At[4][2], B0[2][2], B1[2][2];
    const char* cA = (const char*)g.A + (size_t)cur.pm * tstepA + (size_t)cur.ka * 2; const char* cB = (const char*)g.Bt + (size_t)cur.pn * tstepB;
    PG8_STAGE(PG8_SB(0, 0), cB, voffB); PG8_STAGE(PG8_SB(0, 1), cB + hstepB, voffB); PG8_STAGE(PG8_SA(0, 0), cA, voffA); PG8_STAGE(PG8_SA(0, 1), cA + hstepA, voffA);
    if (wr == 1) PG8_BAR;
    PG8_WAIT_V(2); PG8_BAR;
    PG8_STAGE(PG8_SB(1, 0), cB + kstep, voffB); PG8_STAGE(PG8_SA(1, 0), cA + kstep, voffA); PG8_STAGE(PG8_SB(1, 1), cB + hstepB + kstep, voffB);
    PG8_WAIT_V(6); PG8_BAR;
    for (;;) {
        const bool has_next = S.next(ui + 1, nxt);
        const char* nA = has_next ? (const char*)g.A + (size_t)nxt.pm * tstepA + (size_t)nxt.ka * 2 : cA; const char* nB = has_next ? (const char*)g.Bt + (size_t)nxt.pn * tstepB : cB;
#pragma unroll 1
        for (int t = 0; t < nt; t += 2) {
            const bool last = (t == nt - 2);
            const char* a1 = cA + (size_t)(t + 1) * kstep;
            const char* a2 = last ? nA : cA + (size_t)(t + 2) * kstep; const char* b2 = last ? nB : cB + (size_t)(t + 2) * kstep;
            const char* a3 = a2 + kstep; const char* b3 = b2 + kstep;
            PG8_LDB(B0, 0, 0); PG8_LDB(B1, 0, 1); PG8_SCHED; PG8_LDA(At, 0, 0); PG8_STAGE(PG8_SA(1, 1), a1 + hstepA, voffA);
            PG8_WAIT_V(8); PG8_WAIT_L(0); PG8_BAR; PG8_MMA(0, 0, At, B0); PG8_MMA(0, 1, At, B1); PG8_BAR; PG8_SCHED;
            PG8_LDA(At, 0, 1); PG8_STAGE(PG8_SB(0, 0), b2, voffB); PG8_STAGE(PG8_SB(0, 1), b2 + hstepB, voffB); PG8_STAGE(PG8_SA(0, 0), a2, voffA);
            PG8_WAIT_V(8); PG8_WAIT_L(0); PG8_BAR; PG8_MMA(1, 0, At, B0); PG8_MMA(1, 1, At, B1); PG8_BAR; PG8_SCHED;
            PG8_LDB(B0, 1, 0); PG8_LDB(B1, 1, 1); PG8_SCHED; PG8_LDA(At, 1, 0); PG8_STAGE(PG8_SA(0, 1), a2 + hstepA, voffA);
            PG8_WAIT_V(8); PG8_WAIT_L(0); PG8_BAR; PG8_MMA(0, 0, At, B0); PG8_MMA(0, 1, At, B1); PG8_BAR; PG8_SCHED;
            PG8_LDA(At, 1, 1); PG8_STAGE(PG8_SB(1, 0), b3, voffB); PG8_STAGE(PG8_SB(1, 1), b3 + hstepB, voffB); PG8_STAGE(PG8_SA(1, 0), a3, voffA);
            PG8_WAIT_V(8); PG8_WAIT_L(0); PG8_BAR; PG8_MMA(1, 0, At, B0); PG8_MMA(1, 1, At, B1); PG8_BAR; PG8_SCHED;
        }
        if constexpr (ALIGN_EPI) { if (wr == 0) PG8_BAR; }
        E(acc, cur, wr, wc, fr, fq);
        if (!has_next) break;
        if (!E.keep(cur)) {
#pragma unroll
            for (int a = 0; a < 2; ++a)
#pragma unroll
                for (int b = 0; b < 2; ++b)
#pragma unroll
                    for (int m = 0; m < 4; ++m)
#pragma unroll
                        for (int n = 0; n < 2; ++n) acc[a][b][m][n] = (f32x4){0.f, 0.f, 0.f, 0.f};
        }
        cur = nxt; cA = nA; cB = nB; ++ui;
        if constexpr (ALIGN_EPI) { if (wr == 1) PG8_BAR; }
    }
    PG8_WAIT_V(0);
    if constexpr (!ALIGN_EPI) { if (wr == 0) PG8_BAR; }
    PG8_BAR;
#undef PG8_SA
#undef PG8_SB
#undef PG8_STAGE
#undef PG8_LDA
#undef PG8_LDB
#undef PG8_MMA
#undef PG8_WAIT_V
#undef PG8_WAIT_L
#undef PG8_BAR
#undef PG8_SCHED
}
}
using pg8::Unit;

constexpr size_t MiB = 1u << 20;
constexpr size_t WS_CTL = 0, CTL_ZERO_BYTES = 1 * MiB;
constexpr size_t WS_RT = 1 * MiB;
constexpr size_t RT_E = 0, RT_W = 131072, RT_RANK = 262144, RT_POS = 393216, RT_CNT = 524288;
constexpr size_t WS_CS64 = 4 * MiB, WS_CS32 = 8 * MiB;
constexpr size_t WS_WIN = 10 * MiB, WS_WUP = 23 * MiB, WS_WB = 24 * MiB, WS_WOUT = 26 * MiB, WS_W1 = 28 * MiB, WS_W2 = 44 * MiB;
constexpr size_t WS_H = 52 * MiB;
constexpr size_t WS_MQ = 84 * MiB;
constexpr size_t WS_OBR = 116 * MiB;
constexpr size_t WS_PROJ = 140 * MiB;
constexpr size_t WS_HPERM = 140 * MiB, WS_HID = 212 * MiB, WS_YBUF = 230 * MiB;
constexpr size_t WS_END = 348 * MiB;
static_assert(WS_WIN + (size_t)NPROJ * 1024 * 2 <= WS_WUP && WS_YBUF + (size_t)MROWS * 1024 * 2 <= WS_END && WS_HPERM + (size_t)MROWS * 1024 * 2 <= WS_HID && WS_HID + (size_t)MROWS * 256 * 2 <= WS_YBUF, "ws map");
static_assert(WS_PROJ + (size_t)T * NPROJ * 2 <= WS_END, "ws map 2");
constexpr int CW_BAR = 4096, CW_Q = 8192;

constexpr int RING_BYTES = 131072;
constexpr int LDSCTL_OFF = RING_BYTES;
constexpr int LC_XB = 0, LC_Q = 16, LC_TS = 64  , LC_TOT = 192  , LC_BASE = 256  , LC_SEG = 320  ;
constexpr int LDS_BYTES = 147456;

#define XB_TMO      128
#define XB_XCNT(j)  (256  + 64 * (j))
#define XB_XSUB(j)  (1280 + 64 * (j))
#define XB_XGEN(j)  (2304 + 64 * (j))
#define XB_TOP      3328
#define XB_TOPGEN   3392
#define XCD_BAR_WORDS 3456
#define XB_SPIN_CAP (1u << 18)
DI unsigned xb_ld(unsigned* p)              { return __hip_atomic_load(p, __ATOMIC_RELAXED, __HIP_MEMORY_SCOPE_AGENT); }
DI unsigned xb_add(unsigned* p, unsigned v) { return __hip_atomic_fetch_add(p, v, __ATOMIC_RELAXED, __HIP_MEMORY_SCOPE_AGENT); }
DI unsigned xb_xcc_id() { return (unsigned)__builtin_amdgcn_s_getreg((3 << 11) | 20) & 0xFu; }
#define XB_SPIN(cond, bar) do { unsigned _sp = 0; while (cond) { __builtin_amdgcn_s_sleep(1); \
    if ((++_sp & 255u) == 0u) { if (xb_ld(&(bar)[XB_TMO])) break; if (_sp > XB_SPIN_CAP) { atomicAdd(&(bar)[XB_TMO], 1u); break; } } } } while (0)
struct XcdBarrier { unsigned* bar; unsigned x; volatile LAS unsigned* st; };
DI XcdBarrier xcd_barrier_post(unsigned* bar, volatile LAS unsigned* st) {
    XcdBarrier b; b.bar = bar; b.x = xb_xcc_id(); b.st = st;
    if (threadIdx.x == 0) (void)xb_add(&bar[XB_XCNT(b.x)], 1u);
    return b;
}
DI void xcd_barrier_complete(unsigned* bar, unsigned x, unsigned& nloc, unsigned& nx) {
    const unsigned G = gridDim.x * gridDim.y * gridDim.z;
    unsigned sum, cnt, mine, sp = 0u;
    for (;;) {
        sum = 0u; cnt = 0u; mine = 0u;
#pragma unroll
        for (unsigned j = 0; j < 16; ++j) { const unsigned c = xb_ld(&bar[XB_XCNT(j)]); sum += c; cnt += (c > 0u) ? 1u : 0u; mine = (j == x) ? c : mine; }
        if (sum == G) break;
        __builtin_amdgcn_s_sleep(1);
        if ((++sp & 255u) == 0u) { if (xb_ld(&bar[XB_TMO])) break; if (sp > XB_SPIN_CAP) { atomicAdd(&bar[XB_TMO], 1u); break; } }
    }
    nloc = mine > 0u ? mine : 1u; nx = cnt > 0u ? cnt : 1u;
}
DI void xcd_barrier(const XcdBarrier& b) {
    asm volatile("s_waitcnt vmcnt(0)" ::: "memory");
    __syncthreads();
    if (threadIdx.x == 0) {
        unsigned* bar = b.bar;
        __builtin_amdgcn_s_waitcnt(0);
        unsigned nloc = b.st[0], nx = b.st[1];
        if (nloc == 0u) { xcd_barrier_complete(bar, b.x, nloc, nx); b.st[0] = nloc; b.st[1] = nx; }
        const unsigned old = xb_add(&bar[XB_XSUB(b.x)], 1u);
        const unsigned gen = old / nloc;
        if (old + 1u == (gen + 1u) * nloc) {
            __builtin_amdgcn_fence(__ATOMIC_RELEASE, "agent");
            asm volatile("s_waitcnt vmcnt(0)" ::: "memory");
            const unsigned og = xb_add(&bar[XB_TOP], 1u);
            const unsigned tg = og / nx;
            if (og + 1u == (tg + 1u) * nx) xb_add(&bar[XB_TOPGEN], 1u);
            else XB_SPIN(xb_ld(&bar[XB_TOPGEN]) == tg, bar);
            __builtin_amdgcn_fence(__ATOMIC_ACQUIRE, "agent");
            xb_add(&bar[XB_XGEN(b.x)], 1u);
            asm volatile("s_waitcnt vmcnt(0)" ::: "memory");
        } else {
            XB_SPIN(xb_ld(&bar[XB_XGEN(b.x)]) == gen, bar);
            __builtin_amdgcn_fence(__ATOMIC_ACQUIRE, "agent");
            asm volatile("s_waitcnt vmcnt(0)" ::: "memory");
        }
    }
    __syncthreads();
}

struct Args { const void* in[19]; float* out; unsigned char* ws; int ph_lo, ph_hi; };
struct Frame {
    LAS unsigned char* lds;
    unsigned char* ws; float* out;
    const __attribute__((address_space(4))) Args* ap;
    int tid, lane, wave, vcu, G, bx;
};
DI Frame mkframe() {
    extern __shared__ __attribute__((aligned(16))) unsigned char lds_raw[];
    Frame F;
    F.lds = (LAS unsigned char*)lds_raw;
    int t = threadIdx.x; asm volatile("" : "+v"(t));
    F.tid = t; F.lane = t & 63; F.wave = __builtin_amdgcn_readfirstlane(t >> 6);
    int bx = blockIdx.x, G = gridDim.x; asm volatile("" : "+s"(bx), "+s"(G));
    F.bx = bx; F.G = G; F.vcu = (G % 8 == 0) ? (bx % 8) * (G / 8) + bx / 8 : bx;
    const __attribute__((address_space(4))) Args* ap = (const __attribute__((address_space(4))) Args*)__builtin_amdgcn_kernarg_segment_ptr();
    asm volatile("" : "+s"(ap));
    F.ap = ap; F.ws = ap->ws; F.out = ap->out;
    return F;
}
#define FIN(F, k, ty) ((const ty*)(F).ap->in[k])
#define F_x(F) FIN(F, 0, float)
#define F_pos(F) FIN(F, 1, int)
#define F_g_mix(F) FIN(F, 2, float)
#define F_w_in(F) FIN(F, 3, float)
#define F_g_q_lat(F) FIN(F, 4, float)
#define F_w_uq(F) FIN(F, 5, float)
#define F_g_kv_lat(F) FIN(F, 6, float)
#define F_w_ukv(F) FIN(F, 7, float)
#define F_w_branch(F) FIN(F, 8, float)
#define F_w_out(F) FIN(F, 9, float)
#define F_g_ffn(F) FIN(F, 10, float)
#define F_w_gr(F) FIN(F, 11, float)
#define F_b_gr(F) FIN(F, 12, float)
#define F_w_er(F) FIN(F, 13, float)
#define F_b_er(F) FIN(F, 14, float)
#define F_w_gate(F) FIN(F, 15, float)
#define F_w_up(F) FIN(F, 16, float)
#define F_w_down(F) FIN(F, 17, float)
#define F_g_final(F) FIN(F, 18, float)
#define F_ctl(F) ((unsigned*)((F).ws + WS_CTL))
#define F_tok_e(F) ((int*)((F).ws + WS_RT + RT_E))
#define F_tok_w(F) ((float*)((F).ws + WS_RT + RT_W))
#define F_tok_rank(F) ((int*)((F).ws + WS_RT + RT_RANK))
#define F_tok_pos(F) ((int*)((F).ws + WS_RT + RT_POS))
#define F_blk_cnt(F) ((int*)((F).ws + WS_RT + RT_CNT))
#define F_cs64(F) ((float*)((F).ws + WS_CS64))
#define F_cs32(F) ((float*)((F).ws + WS_CS32))
#define F_Win_t(F) ((bf16*)((F).ws + WS_WIN))
#define F_Wup_t(F) ((bf16*)((F).ws + WS_WUP))
#define F_Wb_t(F) ((bf16*)((F).ws + WS_WB))
#define F_Wout_t(F) ((bf16*)((F).ws + WS_WOUT))
#define F_W1_t(F) ((bf16*)((F).ws + WS_W1))
#define F_W2_t(F) ((bf16*)((F).ws + WS_W2))
#define F_H(F) ((bf16*)((F).ws + WS_H))
#define F_MQ(F) ((bf16*)((F).ws + WS_MQ))
#define F_OBR(F) ((bf16*)((F).ws + WS_OBR))
#define F_PROJ(F) ((bf16*)((F).ws + WS_PROJ))
#define F_HPERM(F) ((bf16*)((F).ws + WS_HPERM))
#define F_HID(F) ((bf16*)((F).ws + WS_HID))
#define F_YBUF(F) ((bf16*)((F).ws + WS_YBUF))
#define LDS_WAIT() asm volatile("s_waitcnt lgkmcnt(0)" ::: "memory")
DI float wave_sum(float v) {
#pragma unroll
    for (int o = 1; o < 64; o <<= 1) v += __shfl_xor(v, o);
    return v;
}

DI void pre_tables(Frame& F) {
    const int gt = F.bx * 512 + F.tid, NT_ = F.G * 512;
    for (int idx = gt; idx < T * 48; idx += NT_) {
        const int t = idx / 48, i = idx % 48;
        const float p = (float)F_pos(F)[t];
        float inv;
        if (i < 32) inv = powf(10000.0f, -(float)(2 * i) / 64.0f); else inv = powf(10000.0f, -(float)(2 * (i - 32)) / 32.0f);
        const float ang = p * inv;
        double rev = (double)ang * 0.15915494309189535; rev -= floor(rev);
        const float rf = (float)rev;
        const float sn = __builtin_amdgcn_sinf(rf), cn = __builtin_amdgcn_cosf(rf);
        if (i < 32) { F_cs64(F)[((size_t)t * 32 + i) * 2] = cn; F_cs64(F)[((size_t)t * 32 + i) * 2 + 1] = sn; }
        else { F_cs32(F)[((size_t)t * 16 + (i - 32)) * 2] = cn; F_cs32(F)[((size_t)t * 16 + (i - 32)) * 2 + 1] = sn; }
    }
}

struct ColSrc { const float* p; int stride; float scale; int klo, khi; const float* kg; };
template <class Map>
DI void conv_item(const Map& mp, int K, int N, bf16* WT, LAS float* scr, int item, int lane) {
    const int nblk = N / 32, kb = item / nblk, nb = item % nblk, k0 = 64 * kb, n0 = 32 * nb;
    const ColSrc cs = mp(n0 + (lane & 31));
#pragma unroll 8
    for (int i = 0; i < 32; ++i) {
        const int kk = 2 * i + (lane >> 5), k = k0 + kk; float v = 0.f;
        if (cs.p != nullptr && k >= cs.klo && k < cs.khi) { v = cs.p[(size_t)(k - cs.klo) * cs.stride] * cs.scale; if (cs.kg) v *= cs.kg[k - cs.klo]; }
        scr[kk * 33 + (lane & 31)] = v;
    }
    LDS_WAIT();
    const int c = lane & 7;
#pragma unroll
    for (int j = 0; j < 4; ++j) { const int n = (lane >> 3) + 8 * j; const LAS float* s = scr + (8 * c) * 33 + n;
        u32x4 o; o.x = pk2(s[0 * 33], s[1 * 33]); o.y = pk2(s[2 * 33], s[3 * 33]); o.z = pk2(s[4 * 33], s[5 * 33]); o.w = pk2(s[6 * 33], s[7 * 33]);
        *(u32x4*)(WT + (size_t)(n0 + n) * K + k0 + 8 * c) = o; }
    LDS_WAIT();
}
struct MapWin { const float* w;
    DI ColSrc operator()(int n) const {
        ColSrc c{nullptr, INC, 1.f, 0, 1024, nullptr};
        if (n < 768) { c.p = w + n; if (n < 256) c.scale = C_SB; }
        else if (n < 1280) { const int j = n - 768; if (j < 384) c.p = w + 768 + j; else if (j < 416) { const int p = j - 384; c.p = w + 1152 + (p >> 1) + 16 * (p & 1); } }
        else if (n < 3584) { const int j = n - 1280, gi = j / 768, rem = j % 768, which = rem >> 8, hd = (rem >> 6) & 3, dd = rem & 63;
            const int sd = which < 2 ? (dd >> 1) + 32 * (dd & 1) : dd; c.p = w + 1184 + gi * 768 + which * 256 + hd * 64 + sd; if (which == 0) c.scale = C_SB; }
        else c.p = w + 3488 + (n - 3584);
        return c; } };
struct MapWup { const float* wuq; const float* wukv; const float* gq; const float* gkv;
    DI ColSrc operator()(int n) const {
        ColSrc c{nullptr, 1, 1.f, 0, 0, nullptr};
        if (n < 384) { const int hd = n / 96, wi = n % 96; const int col = wi < 64 ? hd * 96 + wi : hd * 96 + 64 + ((wi - 64) >> 1) + 16 * ((wi - 64) & 1);
            c.p = wuq + col; c.stride = 384; c.klo = 0; c.khi = 256; c.kg = gq; }
        else if (n < 896) { c.p = wukv + (n - 384); c.stride = 512; c.klo = 256; c.khi = 384; c.kg = gkv; }
        return c; } };
struct MapWb { const float* w;
    DI ColSrc operator()(int n) const { ColSrc c{w + (size_t)(n >> 10) * 256 * 1024 + (n & 1023), 1024, 1.f, 0, 256, nullptr}; return c; } };
struct MapWout { const float* w;
    DI ColSrc operator()(int n) const { ColSrc c{w + n, 1024, 1.f, 0, 1024, nullptr}; return c; } };
struct MapW1 { const float* wg; const float* wu;
    DI ColSrc operator()(int n) const { const int e = n >> 9, rem = n & 511, j = rem >> 8, rr = rem & 255;
        ColSrc c{nullptr, 256, 1.f, 0, 1024, nullptr};
        c.p = (rr < 128) ? wg + (size_t)e * 1024 * 256 + 128 * j + rr : wu + (size_t)e * 1024 * 256 + 128 * j + (rr - 128); return c; } };
struct MapW2 { const float* w;
    DI ColSrc operator()(int n) const { ColSrc c{w + (size_t)(n >> 10) * 256 * 1024 + (n & 1023), 1024, 1.f, 0, 256, nullptr}; return c; } };

DI void conv_phase(Frame& F, int l) {
    LAS float* scr = (LAS float*)(F.lds + F.wave * 16384);
    const int gw = F.vcu * 8 + F.wave, NGW = F.G * 8;
    constexpr int I_IN = 16 * (NPROJ / 32), I_UP = 8 * 32, I_B = 4 * 96, I_O = 16 * 32, I_1 = 16 * 256, I_2 = 4 * 512;
    constexpr int NITEMS = I_IN + I_UP + I_B + I_O + I_1 + I_2;
    const MapWin m_in{F_w_in(F) + (size_t)l * 1024 * INC};
    const MapWup m_up{F_w_uq(F) + (size_t)l * 256 * 384, F_w_ukv(F) + (size_t)l * 128 * 512, F_g_q_lat(F) + l * 256, F_g_kv_lat(F) + l * 128};
    const MapWb m_b{F_w_branch(F) + (size_t)l * 3 * 256 * 1024};
    const MapWout m_o{F_w_out(F) + (size_t)l * 1024 * 1024};
    const MapW1 m_1{F_w_gate(F) + (size_t)l * 16 * 1024 * 256, F_w_up(F) + (size_t)l * 16 * 1024 * 256};
    const MapW2 m_2{F_w_down(F) + (size_t)l * 16 * 256 * 1024};
    for (int it = gw; it < NITEMS; it += NGW) {
        int r = it;
        if (r < I_IN) { conv_item(m_in, 1024, NPROJ, F_Win_t(F), scr, r, F.lane); continue; } r -= I_IN;
        if (r < I_UP) { conv_item(m_up, 512, 1024, F_Wup_t(F), scr, r, F.lane); continue; } r -= I_UP;
        if (r < I_B) { conv_item(m_b, 256, 3072, F_Wb_t(F), scr, r, F.lane); continue; } r -= I_B;
        if (r < I_O) { conv_item(m_o, 1024, 1024, F_Wout_t(F), scr, r, F.lane); continue; } r -= I_O;
        if (r < I_1) { conv_item(m_1, 1024, 8192, F_W1_t(F), scr, r, F.lane); continue; } r -= I_1;
        conv_item(m_2, 256, 16384, F_W2_t(F), scr, r, F.lane);
    }
}

template <bool FINAL>
DI void norm_phase(Frame& F, int l, const float* gain) {
    const int gw = F.vcu * 8 + F.wave, NGW = F.G * 8;
    const float* src = (l == 0) ? F_x(F) : F.out;
    f32x4 g[4];
#pragma unroll
    for (int j = 0; j < 4; ++j) g[j] = *(const f32x4*)(gain + 4 * F.lane + 256 * j);
    for (int m = gw; m < T; m += NGW) {
        f32x4 v[4];
#pragma unroll
        for (int j = 0; j < 4; ++j) v[j] = *(const f32x4*)(src + (size_t)m * D + 4 * F.lane + 256 * j);
        if (l > 0) {
            const int p0 = F_tok_pos(F)[2 * m], p1 = F_tok_pos(F)[2 * m + 1]; const float w0 = F_tok_w(F)[2 * m], w1 = F_tok_w(F)[2 * m + 1];
#pragma unroll
            for (int j = 0; j < 4; ++j) {
                const u32x2 y0 = *(const u32x2*)(F_YBUF(F) + (size_t)p0 * D + 4 * F.lane + 256 * j), y1 = *(const u32x2*)(F_YBUF(F) + (size_t)p1 * D + 4 * F.lane + 256 * j);
                v[j].x += w0 * bflo(y0.x) + w1 * bflo(y1.x); v[j].y += w0 * bfhi(y0.x) + w1 * bfhi(y1.x);
                v[j].z += w0 * bflo(y0.y) + w1 * bflo(y1.y); v[j].w += w0 * bfhi(y0.y) + w1 * bfhi(y1.y);
            }
        }
        float ss = 0.f;
#pragma unroll
        for (int j = 0; j < 4; ++j) ss += (v[j].x * v[j].x + v[j].y * v[j].y) + (v[j].z * v[j].z + v[j].w * v[j].w);
        ss = wave_sum(ss);
        const float rstd = 1.0f / sqrtf(ss * (1.0f / D) + EPS);
        if (FINAL) {
#pragma unroll
            for (int j = 0; j < 4; ++j) *(f32x4*)(F.out + (size_t)m * D + 4 * F.lane + 256 * j) = v[j] * rstd * g[j];
        } else {
#pragma unroll
            for (int j = 0; j < 4; ++j) {
                *(f32x4*)(F.out + (size_t)m * D + 4 * F.lane + 256 * j) = v[j];
                const f32x4 hh = v[j] * rstd * g[j]; u32x2 o; o.x = pk2(hh.x, hh.y); o.y = pk2(hh.z, hh.w);
                *(u32x2*)(F_H(F) + (size_t)m * D + 4 * F.lane + 256 * j) = o;
            }
        }
    }
}

typedef f32x4 AccT[2][2][4][2];
DI void rope4(f32x4& v, const f32x4 t) { const float a = v.x * t.x - v.y * t.y, b = v.x * t.y + v.y * t.x, c = v.z * t.z - v.w * t.w, d = v.z * t.w + v.w * t.z; v = (f32x4){a, b, c, d}; }
DI void store8(bf16* p, const f32x4 v0, const f32x4 v1) { u32x4 w; w.x = pk2(v0.x, v0.y); w.y = pk2(v0.z, v0.w); w.z = pk2(v1.x, v1.y); w.w = pk2(v1.z, v1.w); *(u32x4*)p = w; }

struct EpiInproj {
    static constexpr bool PERM = true;
    bf16* O; const f32x4* cs64; const f32x4* cs32;
    DI bool keep(const Unit&) const { return false; }
    DI void operator()(AccT& acc, const Unit& u, int wr, int wc, int fr, int fq) const {
        const int row0 = u.pm * 256 + wr * 64 + fr;
#pragma unroll
        for (int bj = 0; bj < 2; ++bj) {
            const int cg = u.pn * 256 + bj * 128 + wc * 32;
            int mode = 0;
            if (cg >= PJ_GATE) mode = 3;
            else if (cg >= PJ_DIL) { const int which = ((cg - PJ_DIL) % 768) >> 8; mode = which < 2 ? 1 : 0; }
            else if (cg == PJ_KR) mode = 2;
            const int col0 = cg + 8 * fq;
#pragma unroll
            for (int ai = 0; ai < 2; ++ai)
#pragma unroll
                for (int m = 0; m < 4; ++m) {
                    const int row = row0 + ai * 128 + m * 16;
                    f32x4 v0 = acc[ai][bj][m][0], v1 = acc[ai][bj][m][1];
                    if (mode == 1) { const f32x4* t = cs64 + (size_t)row * 16 + 8 * ((cg >> 5) & 1) + 2 * fq; rope4(v0, t[0]); rope4(v1, t[1]); }
                    else if (mode == 2) { const f32x4* t = cs32 + (size_t)row * 8 + 2 * fq; rope4(v0, t[0]); rope4(v1, t[1]); }
                    else if (mode == 3) {
#pragma unroll
                        for (int e = 0; e < 4; ++e) { v0[e] = fminf(1.0f + fexp2(-LOG2E * v0[e]), 1e30f); v1[e] = fminf(1.0f + fexp2(-LOG2E * v1[e]), 1e30f); }
                    }
                    store8(O + (size_t)row * NPROJ + col0, v0, v1);
                }
        }
    }
};

struct EpiMlaUp {
    static constexpr bool PERM = true;
    bf16* O; const bf16* P; const f32x4* cs32;
    DI bool keep(const Unit&) const { return false; }
    DI void operator()(AccT& acc, const Unit& u, int wr, int wc, int fr, int fq) const {
        const int row0 = u.pm * 256 + wr * 64 + fr;
        float rq[2][4], rkv[2][4];
#pragma unroll
        for (int ai = 0; ai < 2; ++ai)
#pragma unroll
            for (int m = 0; m < 4; ++m) {
                const bf16* pr = P + (size_t)(row0 + ai * 128 + m * 16) * NPROJ + PJ_MLA;
                float sq = 0.f, sk = 0.f;
#pragma unroll
                for (int i = 0; i < 8; ++i) { const u32x4 v = *(const u32x4*)(pr + 64 * fq + 8 * i);
#pragma unroll
                    for (int e = 0; e < 4; ++e) { const float a = bflo(v[e]), b = bfhi(v[e]); sq += a * a + b * b; } }
#pragma unroll
                for (int i = 0; i < 4; ++i) { const u32x4 v = *(const u32x4*)(pr + 256 + 32 * fq + 8 * i);
#pragma unroll
                    for (int e = 0; e < 4; ++e) { const float a = bflo(v[e]), b = bfhi(v[e]); sk += a * a + b * b; } }
                sq += __shfl_xor(sq, 16); sq += __shfl_xor(sq, 32); sk += __shfl_xor(sk, 16); sk += __shfl_xor(sk, 32);
                rq[ai][m] = C_MLA / sqrtf(sq * (1.0f / 256.0f) + EPS); rkv[ai][m] = 1.0f / sqrtf(sk * (1.0f / 128.0f) + EPS);
            }
#pragma unroll
        for (int bj = 0; bj < 2; ++bj) {
            const int gidx = (u.pn * 256 + bj * 128 + wc * 32) >> 5; const bool isq = gidx < 12, rope = isq && (gidx % 3 == 2);
            const int col0 = gidx * 32 + 8 * fq;
#pragma unroll
            for (int ai = 0; ai < 2; ++ai)
#pragma unroll
                for (int m = 0; m < 4; ++m) {
                    const int row = row0 + ai * 128 + m * 16; float sca = rq[ai][m], scb = rkv[ai][m]; asm volatile("" : "+v"(sca), "+v"(scb)); const float sc = isq ? sca : scb;
                    f32x4 v0 = acc[ai][bj][m][0] * sc, v1 = acc[ai][bj][m][1] * sc;
                    if (rope) { const f32x4* t = cs32 + (size_t)row * 8 + 2 * fq; rope4(v0, t[0]); rope4(v1, t[1]); }
                    store8(O + (size_t)row * D + col0, v0, v1);
                }
        }
    }
};

struct EpiMerge {
    static constexpr bool PERM = true;
    bf16* O; const bf16* P;
    DI bool keep(const Unit& u) const { return (u.pn >> 2) < 2; }
    DI void operator()(AccT& acc, const Unit& u, int wr, int wc, int fr, int fq) const {
        const int row0 = u.pm * 256 + wr * 64 + fr, n = u.pn >> 2, jt = u.pn & 3;
#pragma unroll
        for (int bj = 0; bj < 2; ++bj) {
            const int col0 = jt * 256 + bj * 128 + wc * 32 + 8 * fq;
#pragma unroll
            for (int ai = 0; ai < 2; ++ai)
#pragma unroll
                for (int m = 0; m < 4; ++m) {
                    const int row = row0 + ai * 128 + m * 16;
                    const bf16* gp = P + (size_t)row * NPROJ + PJ_GATE + col0;
                    const u32x4 da = *(const u32x4*)(gp + n * 1024);
                    f32x4 f0, f1;
                    f0.x = frcp(bflo(da.x)); f0.y = frcp(bfhi(da.x)); f0.z = frcp(bflo(da.y)); f0.w = frcp(bfhi(da.y));
                    f1.x = frcp(bflo(da.z)); f1.y = frcp(bfhi(da.z)); f1.z = frcp(bflo(da.w)); f1.w = frcp(bfhi(da.w));
                    if (n < 2) {
                        const u32x4 db = *(const u32x4*)(gp + (n + 1) * 1024);
                        f0.x *= bflo(db.x); f0.y *= bfhi(db.x); f0.z *= bflo(db.y); f0.w *= bfhi(db.y);
                        f1.x *= bflo(db.z); f1.y *= bfhi(db.z); f1.z *= bflo(db.w); f1.w *= bfhi(db.w);
                        acc[ai][bj][m][0] *= f0; acc[ai][bj][m][1] *= f1;
                    } else {
                        store8(O + (size_t)row * D + col0, acc[ai][bj][m][0] * f0, acc[ai][bj][m][1] * f1);
                    }
                }
        }
    }
};
struct MergeOrder { int G, c;
    DI bool next(int i, Unit& u) const { const int tile = c + (i / 3) * G; if (tile >= 256) return false; const int n = i % 3; u.pm = tile >> 2; u.pn = n * 4 + (tile & 3); u.ka = n * 256; return true; } };

struct EpiResid {
    static constexpr bool PERM = false;
    float* X;
    DI bool keep(const Unit&) const { return false; }
    DI void operator()(AccT& acc, const Unit& u, int wr, int wc, int fr, int fq) const {
        const int row0 = u.pm * 256 + wr * 64 + fr, colb = u.pn * 256 + wc * 32 + 4 * fq;
#pragma unroll
        for (int ai = 0; ai < 2; ++ai)
#pragma unroll
            for (int m = 0; m < 4; ++m) { float* rp = X + (size_t)(row0 + ai * 128 + m * 16) * D + colb;
#pragma unroll
                for (int bj = 0; bj < 2; ++bj)
#pragma unroll
                    for (int n = 0; n < 2; ++n) { f32x4* p = (f32x4*)(rp + bj * 128 + n * 16); *p = *p + acc[ai][bj][m][n]; } }
    }
};

struct EpiSwiglu {
    static constexpr bool PERM = true;
    bf16* O;
    DI bool keep(const Unit&) const { return false; }
    DI void operator()(AccT& acc, const Unit& u, int wr, int wc, int fr, int fq) const {
        const int row0 = u.pm * 256 + wr * 64 + fr, col0 = (u.pn & 1) * 128 + wc * 32 + 8 * fq;
#pragma unroll
        for (int ai = 0; ai < 2; ++ai)
#pragma unroll
            for (int m = 0; m < 4; ++m) {
                f32x4 r[2];
#pragma unroll
                for (int n = 0; n < 2; ++n) { const f32x4 gt = acc[ai][0][m][n], up = acc[ai][1][m][n];
#pragma unroll
                    for (int e = 0; e < 4; ++e) r[n][e] = gt[e] * up[e] * frcp(1.0f + fexp2(-LOG2E * gt[e])); }
                store8(O + (size_t)(row0 + ai * 128 + m * 16) * 256 + col0, r[0], r[1]);
            }
    }
};
struct EpiY {
    static constexpr bool PERM = true;
    bf16* O;
    DI bool keep(const Unit&) const { return false; }
    DI void operator()(AccT& acc, const Unit& u, int wr, int wc, int fr, int fq) const {
        const int row0 = u.pm * 256 + wr * 64 + fr;
#pragma unroll
        for (int bj = 0; bj < 2; ++bj) { const int col0 = (u.pn & 3) * 256 + bj * 128 + wc * 32 + 8 * fq;
#pragma unroll
            for (int ai = 0; ai < 2; ++ai)
#pragma unroll
                for (int m = 0; m < 4; ++m) store8(O + (size_t)(row0 + ai * 128 + m * 16) * D + col0, acc[ai][bj][m][0], acc[ai][bj][m][1]); }
    }
};
struct MoeOrder { const LAS int* ts; int nN, G, c;
    DI bool next(int i, Unit& u) const {
        const int L = i * G + c; const int ntile = __builtin_amdgcn_readfirstlane(ts[16]); if (L >= ntile * nN) return false;
        const int pm = L / nN, j = L - pm * nN; int e = 0;
#pragma unroll
        for (int k = 1; k < 16; ++k) e += (pm >= ts[k]) ? 1 : 0;
        e = __builtin_amdgcn_readfirstlane(e);
        u.pm = pm; u.pn = e * nN + j; u.ka = 0; return true; } };

DI void route_phase(Frame& F, int l) {
    LAS float* Wr = (LAS float*)F.lds;
    LAS int* eid = (LAS int*)(F.lds + 98304);
    const float* wg = F_w_gr(F) + (size_t)l * 1024 * 4; const float* we = F_w_er(F) + (size_t)l * 1024 * 16;
    for (int i = F.tid; i < 4096; i += 512) Wr[(i & 3) * 1024 + (i >> 2)] = wg[i];
    for (int i = F.tid; i < 16384; i += 512) Wr[(4 + (i & 15)) * 1024 + (i >> 4)] = we[i];
    __syncthreads();
    const int tok0 = F.bx * 64 + F.wave * 8;
    f32x4 xv[8][4], g[4];
#pragma unroll
    for (int j = 0; j < 4; ++j) g[j] = *(const f32x4*)(F_g_ffn(F) + l * 1024 + 4 * F.lane + 256 * j);
#pragma unroll
    for (int i = 0; i < 8; ++i)
#pragma unroll
        for (int j = 0; j < 4; ++j) xv[i][j] = *(const f32x4*)(F.out + (size_t)(tok0 + i) * D + 4 * F.lane + 256 * j);
#pragma unroll
    for (int i = 0; i < 8; ++i) {
        float ss = 0.f;
#pragma unroll
        for (int j = 0; j < 4; ++j) ss += (xv[i][j].x * xv[i][j].x + xv[i][j].y * xv[i][j].y) + (xv[i][j].z * xv[i][j].z + xv[i][j].w * xv[i][j].w);
        ss = wave_sum(ss);
        const float rstd = 1.0f / sqrtf(ss * (1.0f / D) + EPS);
#pragma unroll
        for (int j = 0; j < 4; ++j) { xv[i][j] = xv[i][j] * rstd * g[j]; u32x2 o; o.x = pk2(xv[i][j].x, xv[i][j].y); o.y = pk2(xv[i][j].z, xv[i][j].w);
            *(u32x2*)(F_H(F) + (size_t)(tok0 + i) * D + 4 * F.lane + 256 * j) = o; }
    }
    LAS float* lgs = (LAS float*)(F.lds + 100352) + F.wave * 160;
#pragma unroll 1
    for (int c = 0; c < 20; ++c) {
        f32x4 w[4];
#pragma unroll
        for (int j = 0; j < 4; ++j) w[j] = *(const LAS f32x4*)(Wr + c * 1024 + 4 * F.lane + 256 * j);
#pragma unroll
        for (int i = 0; i < 8; ++i) {
            float p = 0.f;
#pragma unroll
            for (int j = 0; j < 4; ++j) p += (xv[i][j].x * w[j].x + xv[i][j].y * w[j].y) + (xv[i][j].z * w[j].z + xv[i][j].w * w[j].w);
            p = wave_sum(p);
            if (F.lane == 0) lgs[i * 20 + c] = p;
        }
    }
    LDS_WAIT();
    float lg[20];
#pragma unroll
    for (int c = 0; c < 20; ++c) lg[c] = lgs[(F.lane & 7) * 20 + c];
    {
        float gl[4], el[16];
#pragma unroll
        for (int c = 0; c < 4; ++c) gl[c] = lg[c] + F_b_gr(F)[l * 4 + c];
#pragma unroll
        for (int c = 0; c < 16; ++c) el[c] = lg[4 + c] + F_b_er(F)[l * 16 + c];
        int gsel = 0; float best = gl[0];
#pragma unroll
        for (int c = 1; c < 4; ++c) if (gl[c] > best) { best = gl[c]; gsel = c; }
        float den = 0.f;
#pragma unroll
        for (int c = 0; c < 4; ++c) den += expf(gl[c] - best);
        const float pg = 1.0f / den;
        float ig[4];
#pragma unroll
        for (int e = 0; e < 4; ++e) ig[e] = gsel == 0 ? el[e] : gsel == 1 ? el[4 + e] : gsel == 2 ? el[8 + e] : el[12 + e];
        int ia = 0; float va = ig[0];
#pragma unroll
        for (int e = 1; e < 4; ++e) if (ig[e] > va) { va = ig[e]; ia = e; }
        int ib = -1; float vb = -INFINITY;
#pragma unroll
        for (int e = 0; e < 4; ++e) if (e != ia && ig[e] > vb) { vb = ig[e]; ib = e; }
        if (ib < 0) ib = (ia + 1) & 3;
        const float pa = 1.0f / (1.0f + expf(vb - va)), pb = 1.0f - pa;
        if (F.lane < 8) {
            const int t = tok0 + F.lane, e0 = 4 * gsel + ia, e1 = 4 * gsel + ib;
            F_tok_e(F)[2 * t] = e0; F_tok_e(F)[2 * t + 1] = e1; F_tok_w(F)[2 * t] = pg * pa; F_tok_w(F)[2 * t + 1] = pg * pb;
            eid[(F.wave * 8 + F.lane) * 2] = e0; eid[(F.wave * 8 + F.lane) * 2 + 1] = e1;
        }
    }
    __syncthreads();
    if (F.wave == 0) {
        const int e0 = eid[2 * F.lane], e1 = eid[2 * F.lane + 1];
        const unsigned long long lt = (1ull << F.lane) - 1ull;
        int r0 = 0, r1 = 0, cnt = 0;
#pragma unroll
        for (int ee = 0; ee < 16; ++ee) {
            const unsigned long long m0 = __ballot(e0 == ee), m1 = __ballot(e1 == ee);
            const int c0 = __popcll(m0);
            if (e0 == ee) r0 = __popcll(m0 & lt);
            if (e1 == ee) r1 = c0 + __popcll(m1 & lt);
            if (F.lane == ee) cnt = c0 + __popcll(m1);
        }
        const int t = F.bx * 64 + F.lane;
        F_tok_rank(F)[2 * t] = r0; F_tok_rank(F)[2 * t + 1] = r1;
        if (F.lane < 16) F_blk_cnt(F)[F.bx * 16 + F.lane] = cnt;
    }
}

DI void moe_tables(Frame& F) {
    LAS int* ctl = (LAS int*)(F.lds + LDSCTL_OFF);
    if (F.tid < 16) {
        int tot = 0, base = 0;
        for (int b = 0; b < F.G; ++b) { const int c = F_blk_cnt(F)[b * 16 + F.tid]; tot += c; if (b < F.bx) base += c; }
        ctl[LC_TOT / 4 + F.tid] = tot; ctl[LC_BASE / 4 + F.tid] = base;
    }
    __syncthreads();
    if (F.tid == 0) { int acc = 0; for (int e = 0; e < 16; ++e) { ctl[LC_SEG / 4 + e] = acc * 256; ctl[LC_TS / 4 + e] = acc; acc += (ctl[LC_TOT / 4 + e] + 255) >> 8; } ctl[LC_TS / 4 + 16] = acc; }
    __syncthreads();
}

DI void perm_phase(Frame& F) {
    moe_tables(F);
    const LAS int* ctl = (const LAS int*)(F.lds + LDSCTL_OFF);
    for (int i = 0; i < 8; ++i) {
        const int t = F.bx * 64 + F.wave * 8 + i;
#pragma unroll
        for (int k = 0; k < 2; ++k) {
            const int e = F_tok_e(F)[2 * t + k], r = F_tok_rank(F)[2 * t + k];
            const int pos = ctl[LC_SEG / 4 + e] + ctl[LC_BASE / 4 + e] + r;
            if (F.lane == 0) F_tok_pos(F)[2 * t + k] = pos;
            const u32x4* s = (const u32x4*)(F_H(F) + (size_t)t * D); u32x4* d = (u32x4*)(F_HPERM(F) + (size_t)pos * D);
            d[F.lane] = s[F.lane]; d[F.lane + 64] = s[F.lane + 64];
        }
    }
}

#define MFMA32(a, b, c) __builtin_amdgcn_mfma_f32_32x32x16_bf16((a), (b), (c), 0, 0, 0)
DI int crow(int i, int h) { return (i & 3) + 8 * (i >> 2) + 4 * h; }
DI bf16x8 pack8(const f32x16& x, int s) { u32x4 p; p.x = pk2(x[8 * s], x[8 * s + 1]); p.y = pk2(x[8 * s + 2], x[8 * s + 3]); p.z = pk2(x[8 * s + 4], x[8 * s + 5]); p.w = pk2(x[8 * s + 6], x[8 * s + 7]); return __builtin_bit_cast(bf16x8, p); }
DI s16x4 tr_read(const LAS unsigned char* p) { return __builtin_bit_cast(s16x4, __builtin_amdgcn_ds_read_tr16_b64_v4i16((LAS v4i16_t*)p)); }
constexpr int VP = 144;
DI bf16x8 vfrag(const LAS unsigned char* vlane, int off) { const s16x4 lo = tr_read(vlane + off), hi = tr_read(vlane + off + 8 * VP); return __builtin_shufflevector(lo, hi, 0, 1, 2, 3, 4, 5, 6, 7); }
DI void pv_accum(f32x16 (&oT)[2], const LAS unsigned char* vlane, const bf16x8 (&pp)[2][2]) {
#pragma unroll
    for (int blk = 0; blk < 2; ++blk)
#pragma unroll
        for (int s = 0; s < 2; ++s)
#pragma unroll
            for (int db = 0; db < 2; ++db) oT[db] = MFMA32(vfrag(vlane, (32 * blk + 16 * s) * VP + db * 64), pp[blk][s], oT[db]);
}
DI void softmax_tile(const f32x16& s0, const f32x16& s1, float& mrun, float& lrun, f32x16 (&oT)[2], bf16x8 (&pp)[2][2]) {
    float mx = fmaxf(s0[0], s1[0]);
#pragma unroll
    for (int i = 1; i < 16; ++i) mx = fmaxf(mx, fmaxf(s0[i], s1[i]));
    mx = fmaxf(mx, __shfl_xor(mx, 32));
    const float mnew = fmaxf(mrun, mx), alpha = fexp2(mrun - mnew);
    mrun = mnew;
    f32x16 p0, p1; float rs = 0.f;
#pragma unroll
    for (int i = 0; i < 16; ++i) { p0[i] = fexp2(s0[i] - mnew); p1[i] = fexp2(s1[i] - mnew); rs += p0[i] + p1[i]; }
    lrun = lrun * alpha + rs;
#pragma unroll
    for (int i = 0; i < 16; ++i) { oT[0][i] *= alpha; oT[1][i] *= alpha; }
    pp[0][0] = pack8(p0, 0); pp[0][1] = pack8(p0, 1); pp[1][0] = pack8(p1, 0); pp[1][1] = pack8(p1, 1);
}
DI void store_oT(bf16* orow, const f32x16 (&oT)[2], float sc, int h) {
#pragma unroll
    for (int db = 0; db < 2; ++db)
#pragma unroll
        for (int gq = 0; gq < 4; ++gq) { u32x2 w; w.x = pk2(oT[db][4 * gq] * sc, oT[db][4 * gq + 1] * sc); w.y = pk2(oT[db][4 * gq + 2] * sc, oT[db][4 * gq + 3] * sc);
            *(u32x2*)(orow + 32 * db + 8 * gq + 4 * h) = w; }
}

constexpr int SB_KP = 144, SB_TILE = 64 * SB_KP, SB_BUF = 2 * SB_TILE;
DI void sb_unit(Frame& F, int b, int hd, int qb) {
    const int lane = F.lane, r32 = lane & 31, h = lane >> 5, wave = F.wave;
    const int q0w = qb * 256 + wave * 32, qpos = q0w + r32;
    const size_t rowbase = (size_t)b * SEQ;
    const bf16* P = F_PROJ(F);
    bf16x8 qf[4];
#pragma unroll
    for (int s = 0; s < 4; ++s) qf[s] = *(const bf16x8*)(P + (rowbase + qpos) * NPROJ + PJ_SB + hd * 64 + 16 * s + 8 * h);
    bf16x8 tri[2], ones;
#pragma unroll
    for (int s = 0; s < 2; ++s)
#pragma unroll
        for (int j = 0; j < 8; ++j) tri[s][j] = ((16 * s + 8 * (j >> 2) + 4 * h + (j & 3)) > r32) ? (short)0x3F80 : (short)0;
#pragma unroll
    for (int j = 0; j < 8; ++j) ones[j] = (short)0x3F80;
    f32x16 oT[2], carry;
#pragma unroll
    for (int i = 0; i < 16; ++i) { oT[0][i] = 0.f; oT[1][i] = 0.f; carry[i] = 0.f; }
    const int NT = 4 * (qb + 1);
    const int srow = F.tid >> 3, sch = F.tid & 7;
    const bf16* kg = P + (rowbase + srow) * NPROJ + PJ_SB + 256 + hd * 64 + sch * 8;
    u32x4 kreg = *(const u32x4*)(kg + (size_t)(NT - 1) * 64 * NPROJ), vreg = *(const u32x4*)(kg + (size_t)(NT - 1) * 64 * NPROJ + 256);
    const int ldst = srow * SB_KP + sch * 16;
    const int klane = r32 * SB_KP + 16 * h;
    const int vlane_off = (4 * h + ((lane & 15) >> 2)) * VP + ((lane >> 4) & 1) * 32 + (lane & 3) * 8;
    for (int it = 0; it < NT; ++it) {
        const int kt = NT - 1 - it;
        LAS unsigned char* Kb = F.lds + (it & 1) * SB_BUF; LAS unsigned char* Vb = Kb + SB_TILE;
        *(LAS u32x4*)(Kb + ldst) = kreg; *(LAS u32x4*)(Vb + ldst) = vreg;
        __syncthreads();
        if (it + 1 < NT) { kreg = *(const u32x4*)(kg + (size_t)(kt - 1) * 64 * NPROJ); vreg = *(const u32x4*)(kg + (size_t)(kt - 1) * 64 * NPROJ + 256); }
        if (kt * 64 < q0w + 31) {
            f32x16 st0, st1;
#pragma unroll
            for (int i = 0; i < 16; ++i) { st0[i] = 0.f; st1[i] = 0.f; }
#pragma unroll
            for (int s = 0; s < 4; ++s) {
                const bf16x8 k0 = *(const LAS bf16x8*)(Kb + klane + 32 * s), k1 = *(const LAS bf16x8*)(Kb + klane + 32 * SB_KP + 32 * s);
                st0 = MFMA32(k0, qf[s], st0); st1 = MFMA32(k1, qf[s], st1);
            }
            f32x16 sp0, sp1;
            const int kb0 = kt * 64 + 4 * h;
#pragma unroll
            for (int i = 0; i < 16; ++i) {
                const int key0 = kb0 + (i & 3) + 8 * (i >> 2);
                st0[i] = fminf(st0[i], 126.f); st1[i] = fminf(st1[i], 126.f);
                const float a0 = flog2(1.0f + fexp2(st0[i])), a1 = flog2(1.0f + fexp2(st1[i]));
                sp0[i] = (key0 < qpos) ? a0 : 0.f; sp1[i] = (key0 + 32 < qpos) ? a1 : 0.f;
            }
            const bf16x8 s00 = pack8(sp0, 0), s01 = pack8(sp0, 1), s10 = pack8(sp1, 0), s11 = pack8(sp1, 1);
            f32x16 t1 = MFMA32(ones, s10, carry); t1 = MFMA32(ones, s11, t1);
            f32x16 y1 = MFMA32(tri[0], s10, carry); y1 = MFMA32(tri[1], s11, y1);
            f32x16 y0 = MFMA32(tri[0], s00, t1); y0 = MFMA32(tri[1], s01, y0);
            carry = MFMA32(ones, s00, t1); carry = MFMA32(ones, s01, carry);
            f32x16 w0, w1;
#pragma unroll
            for (int i = 0; i < 16; ++i) {
                const int key0 = kb0 + (i & 3) + 8 * (i >> 2);
                const float e0 = fexp2(st0[i] - sp0[i] - y0[i]), e1 = fexp2(st1[i] - sp1[i] - y1[i]);
                w0[i] = (key0 < qpos) ? e0 : 0.f; w1[i] = (key0 + 32 < qpos) ? e1 : 0.f;
            }
            bf16x8 pp[2][2]; pp[0][0] = pack8(w0, 0); pp[0][1] = pack8(w0, 1); pp[1][0] = pack8(w1, 0); pp[1][1] = pack8(w1, 1);
            pv_accum(oT, Vb + vlane_off, pp);
        }
    }
    store_oT(F_OBR(F) + (rowbase + qpos) * 768 + hd * 64, oT, 1.0f, h);
}

constexpr int ML_KP = 208, ML_KT = 64 * ML_KP, ML_BUF = ML_KT + 64 * VP;
DI void mla_unit(Frame& F, int b, int hd, int qb) {
    const int lane = F.lane, r32 = lane & 31, h = lane >> 5, wave = F.wave;
    const int q0w = qb * 256 + wave * 32, qpos = q0w + r32;
    const size_t rowbase = (size_t)b * SEQ;
    const bf16* MQp = F_MQ(F); const bf16* P = F_PROJ(F);
    bf16x8 qf[6];
#pragma unroll
    for (int s = 0; s < 6; ++s) qf[s] = *(const bf16x8*)(MQp + (rowbase + qpos) * D + hd * 96 + 16 * s + 8 * h);
    f32x16 oT[2];
#pragma unroll
    for (int i = 0; i < 16; ++i) { oT[0][i] = 0.f; oT[1][i] = 0.f; }
    float mrun = -1e30f, lrun = 0.f;
    const int NT = 4 * (qb + 1);
    const int i0 = F.tid, i1 = F.tid + 512;
    const int r0 = i0 / 12, c0 = i0 % 12, r1 = i1 / 12, c1 = i1 % 12; const bool has1 = i1 < 768;
    const bf16* kg0 = (c0 < 8) ? MQp + (rowbase + r0) * D + 384 + hd * 128 + c0 * 8 : P + (rowbase + r0) * NPROJ + PJ_KR + (c0 - 8) * 8;
    const size_t ks0 = (c0 < 8) ? (size_t)64 * D : (size_t)64 * NPROJ;
    const bf16* kg1 = (c1 < 8) ? MQp + (rowbase + (has1 ? r1 : 0)) * D + 384 + hd * 128 + c1 * 8 : P + (rowbase + (has1 ? r1 : 0)) * NPROJ + PJ_KR + (c1 - 8) * 8;
    const size_t ks1 = (c1 < 8) ? (size_t)64 * D : (size_t)64 * NPROJ;
    const int vr = F.tid >> 3, vc = F.tid & 7;
    const bf16* vg = MQp + (rowbase + vr) * D + 384 + hd * 128 + 64 + vc * 8;
    u32x4 kreg0 = *(const u32x4*)kg0, kreg1 = (u32x4){0u, 0u, 0u, 0u}, vreg = *(const u32x4*)vg;
    if (has1) kreg1 = *(const u32x4*)kg1;
    const int kd0 = r0 * ML_KP + c0 * 16, kd1 = r1 * ML_KP + c1 * 16, vd = vr * VP + vc * 16;
    const int klane = r32 * ML_KP + 16 * h;
    const int vlane_off = (4 * h + ((lane & 15) >> 2)) * VP + ((lane >> 4) & 1) * 32 + (lane & 3) * 8;
    for (int kt = 0; kt < NT; ++kt) {
        LAS unsigned char* Kb = F.lds + (kt & 1) * ML_BUF; LAS unsigned char* Vb = Kb + ML_KT;
        *(LAS u32x4*)(Kb + kd0) = kreg0; if (has1) *(LAS u32x4*)(Kb + kd1) = kreg1; *(LAS u32x4*)(Vb + vd) = vreg;
        __syncthreads();
        if (kt + 1 < NT) { kreg0 = *(const u32x4*)(kg0 + (size_t)(kt + 1) * ks0); if (has1) kreg1 = *(const u32x4*)(kg1 + (size_t)(kt + 1) * ks1); vreg = *(const u32x4*)(vg + (size_t)(kt + 1) * 64 * D); }
        if (kt * 64 <= q0w + 31) {
            f32x16 st0, st1;
#pragma unroll
            for (int i = 0; i < 16; ++i) { st0[i] = 0.f; st1[i] = 0.f; }
#pragma unroll
            for (int s = 0; s < 6; ++s) {
                const bf16x8 k0 = *(const LAS bf16x8*)(Kb + klane + 32 * s), k1 = *(const LAS bf16x8*)(Kb + klane + 32 * ML_KP + 32 * s);
                st0 = MFMA32(k0, qf[s], st0); st1 = MFMA32(k1, qf[s], st1);
            }
            if (kt * 64 + 63 > q0w) {
                const int kb0 = kt * 64 + 4 * h;
#pragma unroll
                for (int i = 0; i < 16; ++i) { const int key0 = kb0 + (i & 3) + 8 * (i >> 2); if (key0 > qpos) st0[i] = -INFINITY; if (key0 + 32 > qpos) st1[i] = -INFINITY; }
            }
            bf16x8 pp[2][2];
            softmax_tile(st0, st1, mrun, lrun, oT, pp);
            pv_accum(oT, Vb + vlane_off, pp);
        }
    }
    const float ltot = lrun + __shfl_xor(lrun, 32);
    store_oT(F_OBR(F) + (rowbase + qpos) * 768 + 256 + hd * 64, oT, 1.0f / ltot, h);
}

template <int GI>
DI void dil_group(Frame& F, int b, int hd, int P0, int r32, int h, int lane, LAS unsigned char* Vw, float& mrun, float& lrun, f32x16 (&oT)[2]) {
    constexpr int SH = GI == 0 ? 0 : (GI == 1 ? 2 : 4), R = 1 << SH, STEP = 16 >> SH, NTILE = GI == 0 ? 10 : (GI == 1 ? 4 : 3), NSUB = SEQ >> SH;
    const bf16* P = F_PROJ(F);
    const size_t rowbase = (size_t)b * SEQ;
    const int rc = P0 & (R - 1), i0 = P0 >> SH, iq = i0 + STEP * r32, start = i0 - 128;
    const int qcol = PJ_DIL + GI * 768 + hd * 64, kcol = qcol + 256, vcol = qcol + 512;
    bf16x8 qf[4];
#pragma unroll
    for (int s = 0; s < 4; ++s) qf[s] = *(const bf16x8*)(P + (rowbase + P0 + 16 * r32) * NPROJ + qcol + 16 * s + 8 * h);
    const int vlane_off = (4 * h + ((lane & 15) >> 2)) * VP + ((lane >> 4) & 1) * 32 + (lane & 3) * 8;
    for (int kt = 0; kt < NTILE; ++kt) {
        const int kidx0 = start + 64 * kt;
        bf16x8 kf[2][4];
#pragma unroll
        for (int blk = 0; blk < 2; ++blk) {
            int kid = kidx0 + 32 * blk + r32; kid = kid < 0 ? 0 : (kid > NSUB - 1 ? NSUB - 1 : kid);
            const bf16* kp = P + (rowbase + rc + ((size_t)kid << SH)) * NPROJ + kcol + 8 * h;
#pragma unroll
            for (int s = 0; s < 4; ++s) kf[blk][s] = *(const bf16x8*)(kp + 16 * s);
        }
        u32x4 vv[8];
#pragma unroll
        for (int i = 0; i < 8; ++i) {
            int kid = kidx0 + (lane >> 3) + 8 * i; kid = kid < 0 ? 0 : (kid > NSUB - 1 ? NSUB - 1 : kid);
            vv[i] = *(const u32x4*)(P + (rowbase + rc + ((size_t)kid << SH)) * NPROJ + vcol + (lane & 7) * 8);
        }
        asm volatile("" ::: "memory");
#pragma unroll
        for (int i = 0; i < 8; ++i) *(LAS u32x4*)(Vw + ((lane >> 3) + 8 * i) * VP + (lane & 7) * 16) = vv[i];
        LDS_WAIT();
        f32x16 st0, st1;
#pragma unroll
        for (int i = 0; i < 16; ++i) { st0[i] = 0.f; st1[i] = 0.f; }
#pragma unroll
        for (int s = 0; s < 4; ++s) { st0 = MFMA32(kf[0][s], qf[s], st0); st1 = MFMA32(kf[1][s], qf[s], st1); }
#pragma unroll
        for (int i = 0; i < 16; ++i) {
            const int k0 = kidx0 + 4 * h + (i & 3) + 8 * (i >> 2), k1 = k0 + 32;
            if (!(k0 >= 0 && k0 <= iq && k0 >= iq - 128)) st0[i] = -INFINITY;
            if (!(k1 >= 0 && k1 <= iq && k1 >= iq - 128)) st1[i] = -INFINITY;
        }
        bf16x8 pp[2][2];
        softmax_tile(st0, st1, mrun, lrun, oT, pp);
        pv_accum(oT, Vw + vlane_off, pp);
        LDS_WAIT();
    }
}
DI void dil_unit(Frame& F, int b, int hd, int span, int half) {
    const int lane = F.lane, r32 = lane & 31, h = lane >> 5;
    const int P0 = span * 512 + 8 * half + F.wave;
    LAS unsigned char* Vw = F.lds + F.wave * (64 * VP);
    f32x16 oT[2];
#pragma unroll
    for (int i = 0; i < 16; ++i) { oT[0][i] = 0.f; oT[1][i] = 0.f; }
    float mrun = -1e30f, lrun = 0.f;
    dil_group<0>(F, b, hd, P0, r32, h, lane, Vw, mrun, lrun, oT);
    dil_group<1>(F, b, hd, P0, r32, h, lane, Vw, mrun, lrun, oT);
    dil_group<2>(F, b, hd, P0, r32, h, lane, Vw, mrun, lrun, oT);
    const float ltot = lrun + __shfl_xor(lrun, 32);
    store_oT(F_OBR(F) + ((size_t)b * SEQ + P0 + 16 * r32) * 768 + 512 + hd * 64, oT, 1.0f / ltot, h);
}

DI void attn_phase(Frame& F, int l) {
    unsigned* ctr = F_ctl(F) + CW_Q + 64 * l;
    volatile LAS unsigned* slot = (volatile LAS unsigned*)(F.lds + LDSCTL_OFF + LC_Q);
    constexpr unsigned NU = 768;
    for (;;) {
        if (F.tid == 0) *slot = __hip_atomic_fetch_add(ctr, 1u, __ATOMIC_RELAXED, __HIP_MEMORY_SCOPE_AGENT);
        __syncthreads();
        const unsigned u = (unsigned)__builtin_amdgcn_readfirstlane((int)*slot);
        __syncthreads();
        if (u >= NU) break;
        if (u < 512u) {
            const int qb = 31 - (int)(u >> 4), r = (int)(u & 15u), bh = r & 7, b = bh >> 2, hd = bh & 3;
            if (r < 8) sb_unit(F, b, hd, qb); else mla_unit(F, b, hd, qb);
        } else {
            const int j = (int)u - 512; dil_unit(F, j >> 7, (j >> 5) & 3, (j & 31) >> 1, j & 1);
        }
    }
}

constexpr int N_PHASES = 41;

__global__ void __launch_bounds__(512, 2) fwd_kernel(Args a) {
    extern __shared__ __attribute__((aligned(16))) unsigned char lds_raw[];
    {
        LAS unsigned* lc = (LAS unsigned*)((LAS unsigned char*)lds_raw + LDSCTL_OFF);
        for (int u = threadIdx.x; u < (LDS_BYTES - LDSCTL_OFF) / 4; u += 512) lc[u] = 0u;
    }
    __syncthreads();
    const int lo = a.ph_lo, hi = a.ph_hi;
    unsigned* const barw = (unsigned*)(a.ws + WS_CTL) + CW_BAR;
    XcdBarrier bar; bar.bar = barw; bar.x = 0; bar.st = nullptr;
    if (hi - lo > 1) bar = xcd_barrier_post(barw, (volatile LAS unsigned*)((LAS unsigned char*)lds_raw + LDSCTL_OFF + LC_XB));
#define IN(k) (lo <= (k) && (k) < hi)
#define SEAM(k) do { if (IN(k) && IN((k) + 1)) xcd_barrier(bar); } while (0)

    for (int l = 0; l < NLAYER; ++l) {
        const int pb = 10 * l;
        if (IN(pb + 0)) { Frame F = mkframe(); if (l == 0) pre_tables(F); conv_phase(F, l); norm_phase<false>(F, l, F_g_mix(F) + l * 1024); }
        SEAM(pb + 0);
        if (IN(pb + 1)) {
            Frame F = mkframe();
            pg8::Gemm g{F_H(F), F_Win_t(F), 1024, 1024, 1024}; pg8::StaticOrder S; S.init(T, NPROJ, F.G, F.bx);
            EpiInproj E{F_PROJ(F), (const f32x4*)F_cs64(F), (const f32x4*)F_cs32(F)};
            pg8::gemm_phase<EpiInproj, pg8::StaticOrder, true>(F.lds, F.tid, g, S, E);
        }
        SEAM(pb + 1);
        if (IN(pb + 2)) {
            Frame F = mkframe();
            pg8::Gemm g{F_PROJ(F) + PJ_MLA, F_Wup_t(F), NPROJ, 512, 512}; pg8::StaticOrder S; S.init(T, 1024, F.G, F.bx);
            EpiMlaUp E{F_MQ(F), F_PROJ(F), (const f32x4*)F_cs32(F)};
            pg8::gemm_phase<EpiMlaUp, pg8::StaticOrder, false>(F.lds, F.tid, g, S, E);
        }
        SEAM(pb + 2);
        if (IN(pb + 3)) { Frame F = mkframe(); attn_phase(F, l); }
        SEAM(pb + 3);
        if (IN(pb + 4)) {
            Frame F = mkframe();
            pg8::Gemm g{F_OBR(F), F_Wb_t(F), 768, 256, 256}; MergeOrder S{F.G, F.vcu};
            EpiMerge E{F_H(F), F_PROJ(F)};
            pg8::gemm_phase<EpiMerge, MergeOrder, false>(F.lds, F.tid, g, S, E);
        }
        SEAM(pb + 4);
        if (IN(pb + 5)) {
            Frame F = mkframe();
            pg8::Gemm g{F_H(F), F_Wout_t(F), 1024, 1024, 1024}; pg8::StaticOrder S; S.init(T, 1024, F.G, F.bx);
            EpiResid E{F.out};
            pg8::gemm_phase<EpiResid, pg8::StaticOrder, false>(F.lds, F.tid, g, S, E);
        }
        SEAM(pb + 5);
        if (IN(pb + 6)) { Frame F = mkframe(); route_phase(F, l); }
        SEAM(pb + 6);
        if (IN(pb + 7)) { Frame F = mkframe(); perm_phase(F); }
        SEAM(pb + 7);
        if (IN(pb + 8)) {
            Frame F = mkframe();
            moe_tables(F);
            pg8::Gemm g{F_HPERM(F), F_W1_t(F), 1024, 1024, 1024}; MoeOrder S{(const LAS int*)(F.lds + LDSCTL_OFF + LC_TS), 2, F.G, F.vcu};
            EpiSwiglu E{F_HID(F)};
            pg8::gemm_phase<EpiSwiglu, MoeOrder, true>(F.lds, F.tid, g, S, E);
        }
        SEAM(pb + 8);
        if (IN(pb + 9)) {
            Frame F = mkframe();
            moe_tables(F);
            pg8::Gemm g{F_HID(F), F_W2_t(F), 256, 256, 256}; MoeOrder S{(const LAS int*)(F.lds + LDSCTL_OFF + LC_TS), 4, F.G, F.vcu};
            EpiY E{F_YBUF(F)};
            pg8::gemm_phase<EpiY, MoeOrder, true>(F.lds, F.tid, g, S, E);
        }
        SEAM(pb + 9);
    }
    if (IN(40)) { Frame F = mkframe(); norm_phase<true>(F, NLAYER, F_g_final(F)); }
#undef IN
#undef SEAM
}

extern "C" void kernel_launch(void* const* d_in, const int* in_sizes, int n_in, void* d_out, int out_size, void* d_ws, size_t ws_size, hipStream_t stream) {
    static int grid = 0;
    if (grid == 0) {
        if (n_in != 19 || out_size != T * D || ws_size < WS_END) { fprintf(stderr, "kernel_launch: unexpected problem (n_in %d, out %d, ws %zu < %zu)\n", n_in, out_size, ws_size, (size_t)WS_END); grid = -1; return; }
        if (hipFuncSetAttribute((const void*)fwd_kernel, hipFuncAttributeMaxDynamicSharedMemorySize, LDS_BYTES) != hipSuccess) { fprintf(stderr, "kernel_launch: hipFuncSetAttribute failed\n"); grid = -1; return; }
        int per_cu = 0;
        if (hipOccupancyMaxActiveBlocksPerMultiprocessor(&per_cu, (const void*)fwd_kernel, 512, LDS_BYTES) != hipSuccess || per_cu < 1) fprintf(stderr, "kernel_launch: occupancy query reports %d blocks per CU\n", per_cu);
        (void)hipGetLastError();
        grid = 256;
    }
    if (grid < 0) return;
    (void)in_sizes;
    if (hipMemsetAsync((char*)d_ws + WS_CTL, 0, CTL_ZERO_BYTES, stream) != hipSuccess) return;
    Args a{};
    for (int i = 0; i < 19; ++i) a.in[i] = d_in[i];
    a.out = (float*)d_out; a.ws = (unsigned char*)d_ws;
#if MK_PER_PHASE
    for (int p = 0; p < N_PHASES; ++p) { a.ph_lo = p; a.ph_hi = p + 1; hipLaunchKernelGGL(fwd_kernel, dim3(grid), dim3(512), LDS_BYTES, stream, a); }
#else
    a.ph_lo = 0; a.ph_hi = N_PHASES;
    hipLaunchKernelGGL(fwd_kernel, dim3(grid), dim3(512), LDS_BYTES, stream, a);
#endif
}
```

```cpp
#include <hip/hip_runtime.h>
#include <cstdio>
#include <cstdint>

#ifndef MK_PER_PHASE
#define MK_PER_PHASE 0
#endif

#define LAS __attribute__((address_space(3)))
#define GAS __attribute__((address_space(1)))
typedef unsigned short bf16;
typedef short bf16x8 __attribute__((ext_vector_type(8)));
typedef short s16x4 __attribute__((ext_vector_type(4)));
typedef float f32x2 __attribute__((ext_vector_type(2)));
typedef float f32x4 __attribute__((ext_vector_type(4)));
typedef float f32x16 __attribute__((ext_vector_type(16)));
typedef unsigned u32x2 __attribute__((ext_vector_type(2)));
typedef unsigned u32x4 __attribute__((ext_vector_type(4)));
typedef __bf16 bf2_t __attribute__((ext_vector_type(2)));
typedef short v4i16_t __attribute__((ext_vector_type(4)));

#define DI __device__ __forceinline__
DI unsigned pk2(float a, float b) { f32x2 v = {a, b}; return __builtin_bit_cast(unsigned, __builtin_convertvector(v, bf2_t)); }
DI float bflo(unsigned u) { return __uint_as_float(u << 16); }
DI float bfhi(unsigned u) { return __uint_as_float(u & 0xffff0000u); }
DI float fexp2(float x) { return __builtin_amdgcn_exp2f(x); }
DI float flog2(float x) { return __builtin_amdgcn_logf(x); }
DI float frcp(float x) { return __builtin_amdgcn_rcpf(x); }

constexpr int T = 16384, D = 1024, SEQ = 8192, NLAYER = 4;
constexpr int NPROJ = 6656;
constexpr int PJ_SB = 0, PJ_MLA = 768, PJ_KR = 1152, PJ_DIL = 1280, PJ_GATE = 3584;
constexpr int INC = 6560;
constexpr float EPS = 1e-6f;
constexpr float LOG2E = 1.4426950408889634f;
constexpr float C_SB = 0.125f * LOG2E;
constexpr float C_MLA = 0.10206207261596577f * LOG2E;
constexpr int MROWS = 36864;

namespace pg8 {
constexpr int BM = 256, BK = 64, HALF = 128, HTB = HALF * BK * 2, STAGE_BYTES = 8 * HTB, NXCD = 8, WGM = 8;
__host__ __device__ __forceinline__ int lds_byte(int r, int c) { const int st = (r >> 4) * 2 + (c >> 5), rr = r & 15, cc = c & 31, ob = rr * 64 + cc * 2; return st * 1024 + (ob ^ (((ob >> 9) & 1) << 5)); }
__host__ __device__ __forceinline__ void stage_rc(int b, int& R, int& C) { const int st = b / 1024, sb = b % 1024, swz = sb ^ (((sb >> 9) & 1) << 5); R = (st >> 1) * 16 + swz / 64; C = (st & 1) * 32 + (swz % 64) / 2; }
__host__ __device__ __forceinline__ int perm32(int rho) { const int n = rho >> 4, i = rho & 15; return 8 * (i >> 2) + 4 * n + (i & 3); }

struct Unit { int pm, pn, ka; };
struct Gemm { const bf16* A; const bf16* Bt; int lda, ldb, K; };

struct StaticOrder {
    int nM, nN, nwg, G, c;
    __device__ void init(int M, int N, int G_, int c_) { nM = M / BM; nN = N / BM; nwg = nM * nN; G = G_; c = c_; }
    __device__ bool next(int i, Unit& u) const {
        const long L = (long)i * G + c; if (L >= nwg) return false;
        int wgid = (int)L; { const int q = nwg / NXCD, r = nwg % NXCD, xcd = wgid % NXCD, off = wgid / NXCD; wgid = (xcd < r ? xcd * (q + 1) : r * (q + 1) + (xcd - r) * q) + off; }
        const int nig = WGM * nN, gid = wgid / nig, fm = gid * WGM, gsz = (nM - fm) < WGM ? (nM - fm) : WGM;
        u.pm = fm + ((wgid % nig) % gsz); u.pn = (wgid % nig) / gsz; u.ka = 0; return true;
    }
};

template <class Epi, class Sched, bool ALIGN_EPI>
__device__ __forceinline__ void gemm_phase(LAS unsigned char* lds, const int tid, const Gemm g, const Sched& S, const Epi& E) {
    const int wid = __builtin_amdgcn_readfirstlane(tid >> 6), lane = tid & 63, wr = wid >> 2, wc = wid & 3, fr = lane & 15, fq = lane >> 4;
    const int K = g.K, nt = K / BK;
    unsigned voffA[2], voffB[2];
#pragma unroll
    for (int i = 0; i < 2; ++i) { int R, C; stage_rc(tid * 16 + i * 8192, R, C); const int Rb = Epi::PERM ? ((R & ~31) + perm32(R & 31)) : R;
        voffA[i] = (unsigned)(R * g.lda + C) * 2u; voffB[i] = (unsigned)(Rb * g.ldb + C) * 2u; }
    const size_t kstep = (size_t)(BK * 2);
    const size_t hstepA = (size_t)HALF * g.lda * 2, hstepB = (size_t)HALF * g.ldb * 2;
    const size_t tstepA = 2 * hstepA, tstepB = 2 * hstepB;
    const unsigned ldsw = (unsigned)wid * 1024u;
    const int aoff = lds_byte(wr * 64 + fr, fq * 8), boff = lds_byte(wc * 32 + fr, fq * 8);
#define PG8_SA(b, h) (((b) * 2 + (h)) * HTB)
#define PG8_SB(b, h) ((4 + (b) * 2 + (h)) * HTB)
#define PG8_STAGE(bufoff, gbase, voff) do { _Pragma("unroll") for (int _i = 0; _i < 2; ++_i) \
        __builtin_amdgcn_global_load_lds((const unsigned*)((const char*)(gbase) + (voff)[_i]), (LAS unsigned*)(lds + (bufoff) + ldsw + _i * 8192), 16, 0, 0); } while (0)
#define PG8_LDA(dst, b, h) do { _Pragma("unroll") for (int m = 0; m < 4; ++m) _Pragma("unroll") for (int k = 0; k < 2; ++k) dst[m][k] = *(const LAS bf16x8*)(lds + PG8_SA(b, h) + aoff + m * 2048 + k * 1024); } while (0)
#define PG8_LDB(dst, b, h) do { _Pragma("unroll") for (int n = 0; n < 2; ++n) _Pragma("unroll") for (int k = 0; k < 2; ++k) dst[n][k] = *(const LAS bf16x8*)(lds + PG8_SB(b, h) + boff + n * 2048 + k * 1024); } while (0)
#define PG8_MMA(ai, bj, At, Bt) do { __builtin_amdgcn_s_setprio(1); _Pragma("unroll") for (int m = 0; m < 4; ++m) _Pragma("unroll") for (int n = 0; n < 2; ++n) _Pragma("unroll") for (int k = 0; k < 2; ++k) \
        acc[ai][bj][m][n] = __builtin_amdgcn_mfma_f32_16x16x32_bf16(Bt[n][k], At[m][k], acc[ai][bj][m][n], 0, 0, 0); __builtin_amdgcn_s_setprio(0); } while (0)
#define PG8_WAIT_V(n) asm volatile("s_waitcnt vmcnt(" #n ")" ::: "memory")
#define PG8_WAIT_L(n) asm volatile("s_waitcnt lgkmcnt(" #n ")" ::: "memory")
#define PG8_BAR __builtin_amdgcn_s_barrier()
#define PG8_SCHED __builtin_amdgcn_sched_barrier(0)
    Unit cur, nxt; int ui = 0;
    if (!S.next(0, cur)) return;
    f32x4 acc[2][2][4][2];
#pragma unroll
    for (int a = 0; a < 2; ++a)
#pragma unroll
        for (int b = 0; b < 2; ++b)
#pragma unroll
            for (int m = 0; m < 4; ++m)
#pragma unroll
                for (int n = 0; n < 2; ++n) acc[a][b][m][n] = (f32x4){0.f, 0.f, 0.f, 0.f};
    bf16x8 At[4][2], B0[2][2], B1[2][2];
    const char* cA = (const char*)g.A + (size_t)cur.pm * tstepA + (size_t)cur.ka * 2; const char* cB = (const char*)g.Bt + (size_t)cur.pn * tstepB;
    PG8_STAGE(PG8_SB(0, 0), cB, voffB); PG8_STAGE(PG8_SB(0, 1), cB + hstepB, voffB); PG8_STAGE(PG8_SA(0, 0), cA, voffA); PG8_STAGE(PG8_SA(0, 1), cA + hstepA, voffA);
    if (wr == 1) PG8_BAR;
    PG8_WAIT_V(2); PG8_BAR;
    PG8_STAGE(PG8_SB(1, 0), cB + kstep, voffB); PG8_STAGE(PG8_SA(1, 0), cA + kstep, voffA); PG8_STAGE(PG8_SB(1, 1), cB + hstepB + kstep, voffB);
    PG8_WAIT_V(6); PG8_BAR;
    for (;;) {
        const bool has_next = S.next(ui + 1, nxt);
        const char* nA = has_next ? (const char*)g.A + (size_t)nxt.pm * tstepA + (size_t)nxt.ka * 2 : cA; const char* nB = has_next ? (const char*)g.Bt + (size_t)nxt.pn * tstepB : cB;
#pragma unroll 1
        for (int t = 0; t < nt; t += 2) {
            const bool last = (t == nt - 2);
            const char* a1 = cA + (size_t)(t + 1) * kstep;
            const char* a2 = last ? nA : cA + (size_t)(t + 2) * kstep; const char* b2 = last ? nB : cB + (size_t)(t + 2) * kstep;
            const char* a3 = a2 + kstep; const char* b3 = b2 + kstep;
            PG8_LDB(B0, 0, 0); PG8_LDB(B1, 0, 1); PG8_SCHED; PG8_LDA(At, 0, 0); PG8_STAGE(PG8_SA(1, 1), a1 + hstepA, voffA);
            PG8_WAIT_V(8); PG8_WAIT_L(0); PG8_BAR; PG8_MMA(0, 0, At, B0); PG8_MMA(0, 1, At, B1); PG8_BAR; PG8_SCHED;
            PG8_LDA(At, 0, 1); PG8_STAGE(PG8_SB(0, 0), b2, voffB); PG8_STAGE(PG8_SB(0, 1), b2 + hstepB, voffB); PG8_STAGE(PG8_SA(0, 0), a2, voffA);
            PG8_WAIT_V(8); PG8_WAIT_L(0); PG8_BAR; PG8_MMA(1, 0, At, B0); PG8_MMA(1, 1, At, B1); PG8_BAR; PG8_SCHED;
            PG8_LDB(B0, 1, 0); PG8_LDB(B1, 1, 1); PG8_SCHED; PG8_LDA(At, 1, 0); PG8_STAGE(PG8_SA(0, 1), a2 + hstepA, voffA);
            PG8_WAIT_V(8); PG8_WAIT_L(0); PG8_BAR; PG8_MMA(0, 0, At, B0); PG8_MMA(0, 1, At, B1); PG8_BAR; PG8_SCHED;
            PG8_LDA(At, 1, 1); PG8_STAGE(PG8_SB(1, 0), b3, voffB); PG8_STAGE(PG8_SB(1, 1), b3 + hstepB, voffB); PG8_STAGE(PG8_SA(1, 0), a3, voffA);
            PG8_WAIT_V(8); PG8_WAIT_L(0); PG8_BAR; PG8_MMA(1, 0, At, B0); PG8_MMA(1, 1, At, B1); PG8_BAR; PG8_SCHED;
        }
        if constexpr (ALIGN_EPI) { if (wr == 0) PG8_BAR; }
        E(acc, cur, wr, wc, fr, fq);
        if (!has_next) break;
        if (!E.keep(cur)) {
#pragma unroll
            for (int a = 0; a < 2; ++a)
#pragma unroll
                for (int b = 0; b < 2; ++b)
#pragma unroll
                    for (int m = 0; m < 4; ++m)
#pragma unroll
                        for (int n = 0; n < 2; ++n) acc[a][b][m][n] = (f32x4){0.f, 0.f, 0.f, 0.f};
        }
        cur = nxt; cA = nA; cB = nB; ++ui;
        if constexpr (ALIGN_EPI) { if (wr == 1) PG8_BAR; }
    }
    PG8_WAIT_V(0);
    if constexpr (!ALIGN_EPI) { if (wr == 0) PG8_BAR; }
    PG8_BAR;
#undef PG8_SA
#undef PG8_SB
#undef PG8_STAGE
#undef PG8_LDA
#undef PG8_LDB
#undef PG8_MMA
#undef PG8_WAIT_V
#undef PG8_WAIT_L
#undef PG8_BAR
#undef PG8_SCHED
}
}
using pg8::Unit;

constexpr size_t MiB = 1u << 20;
constexpr size_t WS_CTL = 0, CTL_ZERO_BYTES = 1 * MiB;
constexpr size_t WS_RT = 1 * MiB;
constexpr size_t RT_E = 0, RT_W = 131072, RT_RANK = 262144, RT_POS = 393216, RT_CNT = 524288;
constexpr size_t WS_CS64 = 4 * MiB, WS_CS32 = 8 * MiB;
constexpr size_t WS_WIN = 10 * MiB, WS_WUP = 23 * MiB, WS_WB = 24 * MiB, WS_WOUT = 26 * MiB, WS_W1 = 28 * MiB, WS_W2 = 44 * MiB;
constexpr size_t WS_H = 52 * MiB;
constexpr size_t WS_MQ = 84 * MiB;
constexpr size_t WS_OBR = 116 * MiB;
constexpr size_t WS_PROJ = 140 * MiB;
constexpr size_t WS_HPERM = 140 * MiB, WS_HID = 212 * MiB, WS_YBUF = 230 * MiB;
constexpr size_t WS_END = 348 * MiB;
static_assert(WS_WIN + (size_t)NPROJ * 1024 * 2 <= WS_WUP && WS_YBUF + (size_t)MROWS * 1024 * 2 <= WS_END && WS_HPERM + (size_t)MROWS * 1024 * 2 <= WS_HID && WS_HID + (size_t)MROWS * 256 * 2 <= WS_YBUF, "ws map");
static_assert(WS_PROJ + (size_t)T * NPROJ * 2 <= WS_END, "ws map 2");
constexpr int CW_BAR = 4096, CW_Q = 8192;

constexpr int RING_BYTES = 131072;
constexpr int LDSCTL_OFF = RING_BYTES;
constexpr int LC_XB = 0, LC_Q = 16, LC_TS = 64  , LC_TOT = 192  , LC_BASE = 256  , LC_SEG = 320  ;
constexpr int LDS_BYTES = 147456;

#define XB_TMO      128
#define XB_XCNT(j)  (256  + 64 * (j))
#define XB_XSUB(j)  (1280 + 64 * (j))
#define XB_XGEN(j)  (2304 + 64 * (j))
#define XB_TOP      3328
#define XB_TOPGEN   3392
#define XCD_BAR_WORDS 3456
#define XB_SPIN_CAP (1u << 18)
DI unsigned xb_ld(unsigned* p)              { return __hip_atomic_load(p, __ATOMIC_RELAXED, __HIP_MEMORY_SCOPE_AGENT); }
DI unsigned xb_add(unsigned* p, unsigned v) { return __hip_atomic_fetch_add(p, v, __ATOMIC_RELAXED, __HIP_MEMORY_SCOPE_AGENT); }
DI unsigned xb_xcc_id() { return (unsigned)__builtin_amdgcn_s_getreg((3 << 11) | 20) & 0xFu; }
#define XB_SPIN(cond, bar) do { unsigned _sp = 0; while (cond) { __builtin_amdgcn_s_sleep(1); \
    if ((++_sp & 255u) == 0u) { if (xb_ld(&(bar)[XB_TMO])) break; if (_sp > XB_SPIN_CAP) { atomicAdd(&(bar)[XB_TMO], 1u); break; } } } } while (0)
struct XcdBarrier { unsigned* bar; unsigned x; volatile LAS unsigned* st; };
DI XcdBarrier xcd_barrier_post(unsigned* bar, volatile LAS unsigned* st) {
    XcdBarrier b; b.bar = bar; b.x = xb_xcc_id(); b.st = st;
    if (threadIdx.x == 0) (void)xb_add(&bar[XB_XCNT(b.x)], 1u);
    return b;
}
DI void xcd_barrier_complete(unsigned* bar, unsigned x, unsigned& nloc, unsigned& nx) {
    const unsigned G = gridDim.x * gridDim.y * gridDim.z;
    unsigned sum, cnt, mine, sp = 0u;
    for (;;) {
        sum = 0u; cnt = 0u; mine = 0u;
#pragma unroll
        for (unsigned j = 0; j < 16; ++j) { const unsigned c = xb_ld(&bar[XB_XCNT(j)]); sum += c; cnt += (c > 0u) ? 1u : 0u; mine = (j == x) ? c : mine; }
        if (sum == G) break;
        __builtin_amdgcn_s_sleep(1);
        if ((++sp & 255u) == 0u) { if (xb_ld(&bar[XB_TMO])) break; if (sp > XB_SPIN_CAP) { atomicAdd(&bar[XB_TMO], 1u); break; } }
    }
    nloc = mine > 0u ? mine : 1u; nx = cnt > 0u ? cnt : 1u;
}
DI void xcd_barrier(const XcdBarrier& b) {
    asm volatile("s_waitcnt vmcnt(0)" ::: "memory");
    __syncthreads();
    if (threadIdx.x == 0) {
        unsigned* bar = b.bar;
        __builtin_amdgcn_s_waitcnt(0);
        unsigned nloc = b.st[0], nx = b.st[1];
        if (nloc == 0u) { xcd_barrier_complete(bar, b.x, nloc, nx); b.st[0] = nloc; b.st[1] = nx; }
        const unsigned old = xb_add(&bar[XB_XSUB(b.x)], 1u);
        const unsigned gen = old / nloc;
        if (old + 1u == (gen + 1u) * nloc) {
            __builtin_amdgcn_fence(__ATOMIC_RELEASE, "agent");
            asm volatile("s_waitcnt vmcnt(0)" ::: "memory");
            const unsigned og = xb_add(&bar[XB_TOP], 1u);
            const unsigned tg = og / nx;
            if (og + 1u == (tg + 1u) * nx) xb_add(&bar[XB_TOPGEN], 1u);
            else XB_SPIN(xb_ld(&bar[XB_TOPGEN]) == tg, bar);
            __builtin_amdgcn_fence(__ATOMIC_ACQUIRE, "agent");
            xb_add(&bar[XB_XGEN(b.x)], 1u);
            asm volatile("s_waitcnt vmcnt(0)" ::: "memory");
        } else {
            XB_SPIN(xb_ld(&bar[XB_XGEN(b.x)]) == gen, bar);
            __builtin_amdgcn_fence(__ATOMIC_ACQUIRE, "agent");
            asm volatile("s_waitcnt vmcnt(0)" ::: "memory");
        }
    }
    __syncthreads();
}

struct Args { const void* in[19]; float* out; unsigned char* ws; int ph_lo, ph_hi; };
struct Frame {
    LAS unsigned char* lds;
    unsigned char* ws; float* out;
    const __attribute__((address_space(4))) Args* ap;
    int tid, lane, wave, vcu, G, bx;
};
DI Frame mkframe() {
    extern __shared__ __attribute__((aligned(16))) unsigned char lds_raw[];
    Frame F;
    F.lds = (LAS unsigned char*)lds_raw;
    int t = threadIdx.x; asm volatile("" : "+v"(t));
    F.tid = t; F.lane = t & 63; F.wave = __builtin_amdgcn_readfirstlane(t >> 6);
    int bx = blockIdx.x, G = gridDim.x; asm volatile("" : "+s"(bx), "+s"(G));
    F.bx = bx; F.G = G; F.vcu = (G % 8 == 0) ? (bx % 8) * (G / 8) + bx / 8 : bx;
    const __attribute__((address_space(4))) Args* ap = (const __attribute__((address_space(4))) Args*)__builtin_amdgcn_kernarg_segment_ptr();
    asm volatile("" : "+s"(ap));
    F.ap = ap; F.ws = ap->ws; F.out = ap->out;
    return F;
}
#define FIN(F, k, ty) ((const ty*)(F).ap->in[k])
#define F_x(F) FIN(F, 0, float)
#define F_pos(F) FIN(F, 1, int)
#define F_g_mix(F) FIN(F, 2, float)
#define F_w_in(F) FIN(F, 3, float)
#define F_g_q_lat(F) FIN(F, 4, float)
#define F_w_uq(F) FIN(F, 5, float)
#define F_g_kv_lat(F) FIN(F, 6, float)
#define F_w_ukv(F) FIN(F, 7, float)
#define F_w_branch(F) FIN(F, 8, float)
#define F_w_out(F) FIN(F, 9, float)
#define F_g_ffn(F) FIN(F, 10, float)
#define F_w_gr(F) FIN(F, 11, float)
#define F_b_gr(F) FIN(F, 12, float)
#define F_w_er(F) FIN(F, 13, float)
#define F_b_er(F) FIN(F, 14, float)
#define F_w_gate(F) FIN(F, 15, float)
#define F_w_up(F) FIN(F, 16, float)
#define F_w_down(F) FIN(F, 17, float)
#define F_g_final(F) FIN(F, 18, float)
#define F_ctl(F) ((unsigned*)((F).ws + WS_CTL))
#define F_tok_e(F) ((int*)((F).ws + WS_RT + RT_E))
#define F_tok_w(F) ((float*)((F).ws + WS_RT + RT_W))
#define F_tok_rank(F) ((int*)((F).ws + WS_RT + RT_RANK))
#define F_tok_pos(F) ((int*)((F).ws + WS_RT + RT_POS))
#define F_blk_cnt(F) ((int*)((F).ws + WS_RT + RT_CNT))
#define F_cs64(F) ((float*)((F).ws + WS_CS64))
#define F_cs32(F) ((float*)((F).ws + WS_CS32))
#define F_Win_t(F) ((bf16*)((F).ws + WS_WIN))
#define F_Wup_t(F) ((bf16*)((F).ws + WS_WUP))
#define F_Wb_t(F) ((bf16*)((F).ws + WS_WB))
#define F_Wout_t(F) ((bf16*)((F).ws + WS_WOUT))
#define F_W1_t(F) ((bf16*)((F).ws + WS_W1))
#define F_W2_t(F) ((bf16*)((F).ws + WS_W2))
#define F_H(F) ((bf16*)((F).ws + WS_H))
#define F_MQ(F) ((bf16*)((F).ws + WS_MQ))
#define F_OBR(F) ((bf16*)((F).ws + WS_OBR))
#define F_PROJ(F) ((bf16*)((F).ws + WS_PROJ))
#define F_HPERM(F) ((bf16*)((F).ws + WS_HPERM))
#define F_HID(F) ((bf16*)((F).ws + WS_HID))
#define F_YBUF(F) ((bf16*)((F).ws + WS_YBUF))
#define LDS_WAIT() asm volatile("s_waitcnt lgkmcnt(0)" ::: "memory")
template <int CTRL, int RMASK> DI float dpp_add(float v) { const int t = __builtin_amdgcn_update_dpp(0, __float_as_int(v), CTRL, RMASK, 0xf, true); return v + __int_as_float(t); }
DI float wave_sum(float v) {
    v = dpp_add<0xB1, 0xf>(v);
    v = dpp_add<0x4E, 0xf>(v);
    v = dpp_add<0x141, 0xf>(v);
    v = dpp_add<0x140, 0xf>(v);
    v = dpp_add<0x142, 0xa>(v);
    v = dpp_add<0x143, 0xc>(v);
    return __int_as_float(__builtin_amdgcn_readlane(__float_as_int(v), 63));
}

DI void pre_tables(Frame& F) {
    const int gt = F.bx * 512 + F.tid, NT_ = F.G * 512;
    for (int idx = gt; idx < T * 48; idx += NT_) {
        const int t = idx / 48, i = idx % 48;
        const float p = (float)F_pos(F)[t];
        float inv;
        if (i < 32) inv = powf(10000.0f, -(float)(2 * i) / 64.0f); else inv = powf(10000.0f, -(float)(2 * (i - 32)) / 32.0f);
        const float ang = p * inv;
        double rev = (double)ang * 0.15915494309189535; rev -= floor(rev);
        const float rf = (float)rev;
        const float sn = __builtin_amdgcn_sinf(rf), cn = __builtin_amdgcn_cosf(rf);
        if (i < 32) { F_cs64(F)[((size_t)t * 32 + i) * 2] = cn; F_cs64(F)[((size_t)t * 32 + i) * 2 + 1] = sn; }
        else { F_cs32(F)[((size_t)t * 16 + (i - 32)) * 2] = cn; F_cs32(F)[((size_t)t * 16 + (i - 32)) * 2 + 1] = sn; }
    }
}

struct ColSrc { const float* p; int stride; float scale; int klo, khi; const float* kg; };
template <class Map>
DI void conv_item(const Map& mp, int K, int N, bf16* WT, LAS float* scr, int item, int lane, const float* safe) {
    const int nblk = N / 32, kb = item / nblk, nb = item % nblk, k0 = 64 * kb, n0 = 32 * nb;
    const ColSrc cs = mp(n0 + (lane & 31));
    const bool valid = cs.p != nullptr && k0 >= cs.klo && k0 < cs.khi;
    const float* p = valid ? cs.p + (size_t)(k0 - cs.klo) * cs.stride : safe;
    const float* kg = (valid && cs.kg) ? cs.kg + (k0 - cs.klo) : safe;
    const int st = valid ? cs.stride : 0, kst = (valid && cs.kg) ? 1 : 0; const bool hasg = valid && cs.kg != nullptr;
    const float sc = cs.scale;
#pragma unroll 8
    for (int i = 0; i < 32; ++i) {
        const int kk = 2 * i + (lane >> 5);
        float v = p[(size_t)kk * st] * sc;
        if (Map::HAS_KG) { const float gq = kg[kk * kst]; v = hasg ? v * gq : v; }
        v = valid ? v : 0.f;
        scr[kk * 33 + (lane & 31)] = v;
    }
    LDS_WAIT();
    const int c = lane & 7;
#pragma unroll
    for (int j = 0; j < 4; ++j) { const int n = (lane >> 3) + 8 * j; const LAS float* s = scr + (8 * c) * 33 + n;
        u32x4 o; o.x = pk2(s[0 * 33], s[1 * 33]); o.y = pk2(s[2 * 33], s[3 * 33]); o.z = pk2(s[4 * 33], s[5 * 33]); o.w = pk2(s[6 * 33], s[7 * 33]);
        *(u32x4*)(WT + (size_t)(n0 + n) * K + k0 + 8 * c) = o; }
    LDS_WAIT();
}
struct MapWin { const float* w; static constexpr bool HAS_KG = false;
    DI ColSrc operator()(int n) const {
        ColSrc c{nullptr, INC, 1.f, 0, 1024, nullptr};
        if (n < 768) { c.p = w + n; if (n < 256) c.scale = C_SB; }
        else if (n < 1280) { const int j = n - 768; if (j < 384) c.p = w + 768 + j; else if (j < 416) { const int p = j - 384; c.p = w + 1152 + (p >> 1) + 16 * (p & 1); } }
        else if (n < 3584) { const int j = n - 1280, gi = j / 768, rem = j % 768, which = rem >> 8, hd = (rem >> 6) & 3, dd = rem & 63;
            const int sd = which < 2 ? (dd >> 1) + 32 * (dd & 1) : dd; c.p = w + 1184 + gi * 768 + which * 256 + hd * 64 + sd; if (which == 0) c.scale = C_SB; }
        else c.p = w + 3488 + (n - 3584);
        return c; } };
struct MapWup { const float* wuq; const float* wukv; const float* gq; const float* gkv; static constexpr bool HAS_KG = true;
    DI ColSrc operator()(int n) const {
        ColSrc c{nullptr, 1, 1.f, 0, 0, nullptr};
        if (n < 384) { const int hd = n / 96, wi = n % 96; const int col = wi < 64 ? hd * 96 + wi : hd * 96 + 64 + ((wi - 64) >> 1) + 16 * ((wi - 64) & 1);
            c.p = wuq + col; c.stride = 384; c.klo = 0; c.khi = 256; c.kg = gq; }
        else if (n < 896) { c.p = wukv + (n - 384); c.stride = 512; c.klo = 256; c.khi = 384; c.kg = gkv; }
        return c; } };
struct MapWb { const float* w; static constexpr bool HAS_KG = false;
    DI ColSrc operator()(int n) const { ColSrc c{w + (size_t)(n >> 10) * 256 * 1024 + (n & 1023), 1024, 1.f, 0, 256, nullptr}; return c; } };
struct MapWout { const float* w; static constexpr bool HAS_KG = false;
    DI ColSrc operator()(int n) const { ColSrc c{w + n, 1024, 1.f, 0, 1024, nullptr}; return c; } };
struct MapW1 { const float* wg; const float* wu; static constexpr bool HAS_KG = false;
    DI ColSrc operator()(int n) const { const int e = n >> 9, rem = n & 511, j = rem >> 8, rr = rem & 255;
        ColSrc c{nullptr, 256, 1.f, 0, 1024, nullptr};
        c.p = (rr < 128) ? wg + (size_t)e * 1024 * 256 + 128 * j + rr : wu + (size_t)e * 1024 * 256 + 128 * j + (rr - 128); return c; } };
struct MapW2 { const float* w; static constexpr bool HAS_KG = false;
    DI ColSrc operator()(int n) const { ColSrc c{w + (size_t)(n >> 10) * 256 * 1024 + (n & 1023), 1024, 1.f, 0, 256, nullptr}; return c; } };

DI void conv_phase(Frame& F, int l) {
    LAS float* scr = (LAS float*)(F.lds + F.wave * 16384);
    const int gw = F.vcu * 8 + F.wave, NGW = F.G * 8;
    constexpr int I_IN = 16 * (NPROJ / 32), I_UP = 8 * 32, I_B = 4 * 96, I_O = 16 * 32, I_1 = 16 * 256, I_2 = 4 * 512;
    constexpr int NITEMS = I_IN + I_UP + I_B + I_O + I_1 + I_2;
    const MapWin m_in{F_w_in(F) + (size_t)l * 1024 * INC};
    const MapWup m_up{F_w_uq(F) + (size_t)l * 256 * 384, F_w_ukv(F) + (size_t)l * 128 * 512, F_g_q_lat(F) + l * 256, F_g_kv_lat(F) + l * 128};
    const MapWb m_b{F_w_branch(F) + (size_t)l * 3 * 256 * 1024};
    const MapWout m_o{F_w_out(F) + (size_t)l * 1024 * 1024};
    const MapW1 m_1{F_w_gate(F) + (size_t)l * 16 * 1024 * 256, F_w_up(F) + (size_t)l * 16 * 1024 * 256};
    const MapW2 m_2{F_w_down(F) + (size_t)l * 16 * 256 * 1024};
    const float* safe = F_g_final(F);
    for (int it = gw; it < NITEMS; it += NGW) {
        int r = it;
        if (r < I_IN) { conv_item(m_in, 1024, NPROJ, F_Win_t(F), scr, r, F.lane, safe); continue; } r -= I_IN;
        if (r < I_UP) { conv_item(m_up, 512, 1024, F_Wup_t(F), scr, r, F.lane, safe); continue; } r -= I_UP;
        if (r < I_B) { conv_item(m_b, 256, 3072, F_Wb_t(F), scr, r, F.lane, safe); continue; } r -= I_B;
        if (r < I_O) { conv_item(m_o, 1024, 1024, F_Wout_t(F), scr, r, F.lane, safe); continue; } r -= I_O;
        if (r < I_1) { conv_item(m_1, 1024, 8192, F_W1_t(F), scr, r, F.lane, safe); continue; } r -= I_1;
        conv_item(m_2, 256, 16384, F_W2_t(F), scr, r, F.lane, safe);
    }
}

template <bool FINAL>
DI void norm_phase(Frame& F, int l, const float* gain) {
    const int gw = F.vcu * 8 + F.wave, NGW = F.G * 8;
    const float* src = (l == 0) ? F_x(F) : F.out;
    const int lo4 = 4 * F.lane;
    constexpr int R = 4;
    for (int m0 = gw; m0 < T; m0 += NGW * R) {
        f32x4 v[R][4];
#pragma unroll
        for (int r = 0; r < R; ++r)
#pragma unroll
            for (int j = 0; j < 4; ++j) v[r][j] = *(const f32x4*)(src + (size_t)(m0 + r * NGW) * D + lo4 + 256 * j);
        if (l > 0) {
            int p0[R], p1[R]; float w0[R], w1[R];
#pragma unroll
            for (int r = 0; r < R; ++r) { const int m = m0 + r * NGW; p0[r] = F_tok_pos(F)[2 * m]; p1[r] = F_tok_pos(F)[2 * m + 1]; w0[r] = F_tok_w(F)[2 * m]; w1[r] = F_tok_w(F)[2 * m + 1]; }
#pragma unroll
            for (int r = 0; r < R; ++r)
#pragma unroll
                for (int j = 0; j < 4; ++j) {
                    const u32x2 y0 = *(const u32x2*)(F_YBUF(F) + (size_t)p0[r] * D + lo4 + 256 * j), y1 = *(const u32x2*)(F_YBUF(F) + (size_t)p1[r] * D + lo4 + 256 * j);
                    v[r][j].x += w0[r] * bflo(y0.x) + w1[r] * bflo(y1.x); v[r][j].y += w0[r] * bfhi(y0.x) + w1[r] * bfhi(y1.x);
                    v[r][j].z += w0[r] * bflo(y0.y) + w1[r] * bflo(y1.y); v[r][j].w += w0[r] * bfhi(y0.y) + w1[r] * bfhi(y1.y);
                }
        }
#pragma unroll
        for (int r = 0; r < R; ++r) {
            const int m = m0 + r * NGW;
            float ss = 0.f;
#pragma unroll
            for (int j = 0; j < 4; ++j) ss += (v[r][j].x * v[r][j].x + v[r][j].y * v[r][j].y) + (v[r][j].z * v[r][j].z + v[r][j].w * v[r][j].w);
            ss = wave_sum(ss);
            const float rstd = 1.0f / sqrtf(ss * (1.0f / D) + EPS);
#pragma unroll
            for (int j = 0; j < 4; ++j) {
                const f32x4 g = *(const f32x4*)(gain + lo4 + 256 * j);
                if (FINAL) { *(f32x4*)(F.out + (size_t)m * D + lo4 + 256 * j) = v[r][j] * rstd * g; }
                else {
                    *(f32x4*)(F.out + (size_t)m * D + lo4 + 256 * j) = v[r][j];
                    const f32x4 hh = v[r][j] * rstd * g; u32x2 o; o.x = pk2(hh.x, hh.y); o.y = pk2(hh.z, hh.w);
                    *(u32x2*)(F_H(F) + (size_t)m * D + lo4 + 256 * j) = o;
                }
            }
        }
    }
}

typedef f32x4 AccT[2][2][4][2];
DI void rope4(f32x4& v, const f32x4 t) { const float a = v.x * t.x - v.y * t.y, b = v.x * t.y + v.y * t.x, c = v.z * t.z - v.w * t.w, d = v.z * t.w + v.w * t.z; v = (f32x4){a, b, c, d}; }
DI void store8(bf16* p, const f32x4 v0, const f32x4 v1) { u32x4 w; w.x = pk2(v0.x, v0.y); w.y = pk2(v0.z, v0.w); w.z = pk2(v1.x, v1.y); w.w = pk2(v1.z, v1.w); *(u32x4*)p = w; }

struct EpiInproj {
    static constexpr bool PERM = true;
    bf16* O; const f32x4* cs64; const f32x4* cs32;
    DI bool keep(const Unit&) const { return false; }
    DI void operator()(AccT& acc, const Unit& u, int wr, int wc, int fr, int fq) const {
        const int row0 = u.pm * 256 + wr * 64 + fr;
#pragma unroll
        for (int bj = 0; bj < 2; ++bj) {
            const int cg = u.pn * 256 + bj * 128 + wc * 32;
            int mode = 0;
            if (cg >= PJ_GATE) mode = 3;
            else if (cg >= PJ_DIL) { const int which = ((cg - PJ_DIL) % 768) >> 8; mode = which < 2 ? 1 : 0; }
            else if (cg == PJ_KR) mode = 2;
            const int col0 = cg + 8 * fq;
#pragma unroll
            for (int ai = 0; ai < 2; ++ai)
#pragma unroll
                for (int m = 0; m < 4; ++m) {
                    const int row = row0 + ai * 128 + m * 16;
                    f32x4 v0 = acc[ai][bj][m][0], v1 = acc[ai][bj][m][1];
                    if (mode == 1) { const f32x4* t = cs64 + (size_t)row * 16 + 8 * ((cg >> 5) & 1) + 2 * fq; rope4(v0, t[0]); rope4(v1, t[1]); }
                    else if (mode == 2) { const f32x4* t = cs32 + (size_t)row * 8 + 2 * fq; rope4(v0, t[0]); rope4(v1, t[1]); }
                    else if (mode == 3) {
#pragma unroll
                        for (int e = 0; e < 4; ++e) { v0[e] = fminf(1.0f + fexp2(-LOG2E * v0[e]), 1e30f); v1[e] = fminf(1.0f + fexp2(-LOG2E * v1[e]), 1e30f); }
                    }
                    store8(O + (size_t)row * NPROJ + col0, v0, v1);
                }
        }
    }
};

struct EpiMlaUp {
    static constexpr bool PERM = true;
    bf16* O; const bf16* P; const f32x4* cs32;
    DI bool keep(const Unit&) const { return false; }
    DI void operator()(AccT& acc, const Unit& u, int wr, int wc, int fr, int fq) const {
        const int row0 = u.pm * 256 + wr * 64 + fr;
        float rq[2][4], rkv[2][4];
#pragma unroll
        for (int ai = 0; ai < 2; ++ai)
#pragma unroll
            for (int m = 0; m < 4; ++m) {
                const bf16* pr = P + (size_t)(row0 + ai * 128 + m * 16) * NPROJ + PJ_MLA;
                float sq = 0.f, sk = 0.f;
#pragma unroll
                for (int i = 0; i < 8; ++i) { const u32x4 v = *(const u32x4*)(pr + 64 * fq + 8 * i);
#pragma unroll
                    for (int e = 0; e < 4; ++e) { const float a = bflo(v[e]), b = bfhi(v[e]); sq += a * a + b * b; } }
#pragma unroll
                for (int i = 0; i < 4; ++i) { const u32x4 v = *(const u32x4*)(pr + 256 + 32 * fq + 8 * i);
#pragma unroll
                    for (int e = 0; e < 4; ++e) { const float a = bflo(v[e]), b = bfhi(v[e]); sk += a * a + b * b; } }
                sq += __shfl_xor(sq, 16); sq += __shfl_xor(sq, 32); sk += __shfl_xor(sk, 16); sk += __shfl_xor(sk, 32);
                rq[ai][m] = C_MLA / sqrtf(sq * (1.0f / 256.0f) + EPS); rkv[ai][m] = 1.0f / sqrtf(sk * (1.0f / 128.0f) + EPS);
            }
#pragma unroll
        for (int bj = 0; bj < 2; ++bj) {
            const int gidx = (u.pn * 256 + bj * 128 + wc * 32) >> 5; const bool isq = gidx < 12, rope = isq && (gidx % 3 == 2);
            const int col0 = gidx * 32 + 8 * fq;
#pragma unroll
            for (int ai = 0; ai < 2; ++ai)
#pragma unroll
                for (int m = 0; m < 4; ++m) {
                    const int row = row0 + ai * 128 + m * 16; float sca = rq[ai][m], scb = rkv[ai][m]; asm volatile("" : "+v"(sca), "+v"(scb)); const float sc = isq ? sca : scb;
                    f32x4 v0 = acc[ai][bj][m][0] * sc, v1 = acc[ai][bj][m][1] * sc;
                    if (rope) { const f32x4* t = cs32 + (size_t)row * 8 + 2 * fq; rope4(v0, t[0]); rope4(v1, t[1]); }
                    store8(O + (size_t)row * D + col0, v0, v1);
                }
        }
    }
};

struct EpiMerge {
    static constexpr bool PERM = true;
    bf16* O; const bf16* P;
    DI bool keep(const Unit& u) const { return (u.pn >> 2) < 2; }
    DI void operator()(AccT& acc, const Unit& u, int wr, int wc, int fr, int fq) const {
        const int row0 = u.pm * 256 + wr * 64 + fr, n = u.pn >> 2, jt = u.pn & 3;
#pragma unroll
        for (int bj = 0; bj < 2; ++bj) {
            const int col0 = jt * 256 + bj * 128 + wc * 32 + 8 * fq;
#pragma unroll
            for (int ai = 0; ai < 2; ++ai)
#pragma unroll
                for (int m = 0; m < 4; ++m) {
                    const int row = row0 + ai * 128 + m * 16;
                    const bf16* gp = P + (size_t)row * NPROJ + PJ_GATE + col0;
                    const u32x4 da = *(const u32x4*)(gp + n * 1024);
                    f32x4 f0, f1;
                    f0.x = frcp(bflo(da.x)); f0.y = frcp(bfhi(da.x)); f0.z = frcp(bflo(da.y)); f0.w = frcp(bfhi(da.y));
                    f1.x = frcp(bflo(da.z)); f1.y = frcp(bfhi(da.z)); f1.z = frcp(bflo(da.w)); f1.w = frcp(bfhi(da.w));
                    if (n < 2) {
                        const u32x4 db = *(const u32x4*)(gp + (n + 1) * 1024);
                        f0.x *= bflo(db.x); f0.y *= bfhi(db.x); f0.z *= bflo(db.y); f0.w *= bfhi(db.y);
                        f1.x *= bflo(db.z); f1.y *= bfhi(db.z); f1.z *= bflo(db.w); f1.w *= bfhi(db.w);
                        acc[ai][bj][m][0] *= f0; acc[ai][bj][m][1] *= f1;
                    } else {
                        store8(O + (size_t)row * D + col0, acc[ai][bj][m][0] * f0, acc[ai][bj][m][1] * f1);
                    }
                }
        }
    }
};
struct MergeOrder { int G, c;
    DI bool next(int i, Unit& u) const { const int tile = c + (i / 3) * G; if (tile >= 256) return false; const int n = i % 3; u.pm = tile >> 2; u.pn = n * 4 + (tile & 3); u.ka = n * 256; return true; } };

struct EpiResid {
    static constexpr bool PERM = false;
    float* X;
    DI bool keep(const Unit&) const { return false; }
    DI void operator()(AccT& acc, const Unit& u, int wr, int wc, int fr, int fq) const {
        const int row0 = u.pm * 256 + wr * 64 + fr, colb = u.pn * 256 + wc * 32 + 4 * fq;
#pragma unroll
        for (int ai = 0; ai < 2; ++ai)
#pragma unroll
            for (int m = 0; m < 4; ++m) { float* rp = X + (size_t)(row0 + ai * 128 + m * 16) * D + colb;
#pragma unroll
                for (int bj = 0; bj < 2; ++bj)
#pragma unroll
                    for (int n = 0; n < 2; ++n) { f32x4* p = (f32x4*)(rp + bj * 128 + n * 16); *p = *p + acc[ai][bj][m][n]; } }
    }
};

struct EpiSwiglu {
    static constexpr bool PERM = true;
    bf16* O;
    DI bool keep(const Unit&) const { return false; }
    DI void operator()(AccT& acc, const Unit& u, int wr, int wc, int fr, int fq) const {
        const int row0 = u.pm * 256 + wr * 64 + fr, col0 = (u.pn & 1) * 128 + wc * 32 + 8 * fq;
#pragma unroll
        for (int ai = 0; ai < 2; ++ai)
#pragma unroll
            for (int m = 0; m < 4; ++m) {
                f32x4 r[2];
#pragma unroll
                for (int n = 0; n < 2; ++n) { const f32x4 gt = acc[ai][0][m][n], up = acc[ai][1][m][n];
#pragma unroll
                    for (int e = 0; e < 4; ++e) r[n][e] = gt[e] * up[e] * frcp(1.0f + fexp2(-LOG2E * gt[e])); }
                store8(O + (size_t)(row0 + ai * 128 + m * 16) * 256 + col0, r[0], r[1]);
            }
    }
};
struct EpiY {
    static constexpr bool PERM = true;
    bf16* O;
    DI bool keep(const Unit&) const { return false; }
    DI void operator()(AccT& acc, const Unit& u, int wr, int wc, int fr, int fq) const {
        const int row0 = u.pm * 256 + wr * 64 + fr;
#pragma unroll
        for (int bj = 0; bj < 2; ++bj) { const int col0 = (u.pn & 3) * 256 + bj * 128 + wc * 32 + 8 * fq;
#pragma unroll
            for (int ai = 0; ai < 2; ++ai)
#pragma unroll
                for (int m = 0; m < 4; ++m) store8(O + (size_t)(row0 + ai * 128 + m * 16) * D + col0, acc[ai][bj][m][0], acc[ai][bj][m][1]); }
    }
};
struct MoeOrder { const LAS int* ts; int nN, G, c;
    DI bool next(int i, Unit& u) const {
        const int L = i * G + c; const int ntile = __builtin_amdgcn_readfirstlane(ts[16]); if (L >= ntile * nN) return false;
        const int pm = L / nN, j = L - pm * nN; int e = 0;
#pragma unroll
        for (int k = 1; k < 16; ++k) e += (pm >= ts[k]) ? 1 : 0;
        e = __builtin_amdgcn_readfirstlane(e);
        u.pm = pm; u.pn = e * nN + j; u.ka = 0; return true; } };

DI void route_phase(Frame& F, int l) {
    LAS float* Wr = (LAS float*)F.lds;
    LAS int* eid = (LAS int*)(F.lds + 98304);
    const float* wg = F_w_gr(F) + (size_t)l * 1024 * 4; const float* we = F_w_er(F) + (size_t)l * 1024 * 16;
    for (int i = F.tid; i < 4096; i += 512) Wr[(i & 3) * 1024 + (i >> 2)] = wg[i];
    for (int i = F.tid; i < 16384; i += 512) Wr[(4 + (i & 15)) * 1024 + (i >> 4)] = we[i];
    __syncthreads();
    const int tok0 = F.bx * 64 + F.wave * 8;
    f32x4 xv[8][4], g[4];
#pragma unroll
    for (int j = 0; j < 4; ++j) g[j] = *(const f32x4*)(F_g_ffn(F) + l * 1024 + 4 * F.lane + 256 * j);
#pragma unroll
    for (int i = 0; i < 8; ++i)
#pragma unroll
        for (int j = 0; j < 4; ++j) xv[i][j] = *(const f32x4*)(F.out + (size_t)(tok0 + i) * D + 4 * F.lane + 256 * j);
#pragma unroll
    for (int i = 0; i < 8; ++i) {
        float ss = 0.f;
#pragma unroll
        for (int j = 0; j < 4; ++j) ss += (xv[i][j].x * xv[i][j].x + xv[i][j].y * xv[i][j].y) + (xv[i][j].z * xv[i][j].z + xv[i][j].w * xv[i][j].w);
        ss = wave_sum(ss);
        const float rstd = 1.0f / sqrtf(ss * (1.0f / D) + EPS);
#pragma unroll
        for (int j = 0; j < 4; ++j) { xv[i][j] = xv[i][j] * rstd * g[j]; u32x2 o; o.x = pk2(xv[i][j].x, xv[i][j].y); o.y = pk2(xv[i][j].z, xv[i][j].w);
            *(u32x2*)(F_H(F) + (size_t)(tok0 + i) * D + 4 * F.lane + 256 * j) = o; }
    }
    LAS float* lgs = (LAS float*)(F.lds + 100352) + F.wave * 160;
#pragma unroll 1
    for (int c = 0; c < 20; ++c) {
        f32x4 w[4];
#pragma unroll
        for (int j = 0; j < 4; ++j) w[j] = *(const LAS f32x4*)(Wr + c * 1024 + 4 * F.lane + 256 * j);
#pragma unroll
        for (int i = 0; i < 8; ++i) {
            float p = 0.f;
#pragma unroll
            for (int j = 0; j < 4; ++j) p += (xv[i][j].x * w[j].x + xv[i][j].y * w[j].y) + (xv[i][j].z * w[j].z + xv[i][j].w * w[j].w);
            p = wave_sum(p);
            if (F.lane == 0) lgs[i * 20 + c] = p;
        }
    }
    LDS_WAIT();
    float lg[20];
#pragma unroll
    for (int c = 0; c < 20; ++c) lg[c] = lgs[(F.lane & 7) * 20 + c];
    {
        float gl[4], el[16];
#pragma unroll
        for (int c = 0; c < 4; ++c) gl[c] = lg[c] + F_b_gr(F)[l * 4 + c];
#pragma unroll
        for (int c = 0; c < 16; ++c) el[c] = lg[4 + c] + F_b_er(F)[l * 16 + c];
        int gsel = 0; float best = gl[0];
#pragma unroll
        for (int c = 1; c < 4; ++c) if (gl[c] > best) { best = gl[c]; gsel = c; }
        float den = 0.f;
#pragma unroll
        for (int c = 0; c < 4; ++c) den += expf(gl[c] - best);
        const float pg = 1.0f / den;
        float ig[4];
#pragma unroll
        for (int e = 0; e < 4; ++e) ig[e] = gsel == 0 ? el[e] : gsel == 1 ? el[4 + e] : gsel == 2 ? el[8 + e] : el[12 + e];
        int ia = 0; float va = ig[0];
#pragma unroll
        for (int e = 1; e < 4; ++e) if (ig[e] > va) { va = ig[e]; ia = e; }
        int ib = -1; float vb = -INFINITY;
#pragma unroll
        for (int e = 0; e < 4; ++e) if (e != ia && ig[e] > vb) { vb = ig[e]; ib = e; }
        if (ib < 0) ib = (ia + 1) & 3;
        const float pa = 1.0f / (1.0f + expf(vb - va)), pb = 1.0f - pa;
        if (F.lane < 8) {
            const int t = tok0 + F.lane, e0 = 4 * gsel + ia, e1 = 4 * gsel + ib;
            F_tok_e(F)[2 * t] = e0; F_tok_e(F)[2 * t + 1] = e1; F_tok_w(F)[2 * t] = pg * pa; F_tok_w(F)[2 * t + 1] = pg * pb;
            eid[(F.wave * 8 + F.lane) * 2] = e0; eid[(F.wave * 8 + F.lane) * 2 + 1] = e1;
        }
    }
    __syncthreads();
    if (F.wave == 0) {
        const int e0 = eid[2 * F.lane], e1 = eid[2 * F.lane + 1];
        const unsigned long long lt = (1ull << F.lane) - 1ull;
        int r0 = 0, r1 = 0, cnt = 0;
#pragma unroll
        for (int ee = 0; ee < 16; ++ee) {
            const unsigned long long m0 = __ballot(e0 == ee), m1 = __ballot(e1 == ee);
            const int c0 = __popcll(m0);
            if (e0 == ee) r0 = __popcll(m0 & lt);
            if (e1 == ee) r1 = c0 + __popcll(m1 & lt);
            if (F.lane == ee) cnt = c0 + __popcll(m1);
        }
        const int t = F.bx * 64 + F.lane;
        F_tok_rank(F)[2 * t] = r0; F_tok_rank(F)[2 * t + 1] = r1;
        if (F.lane < 16) F_blk_cnt(F)[F.bx * 16 + F.lane] = cnt;
    }
}

DI void moe_tables(Frame& F) {
    LAS int* ctl = (LAS int*)(F.lds + LDSCTL_OFF);
    if (F.tid < 32) ctl[LC_TOT / 4 + F.tid] = 0;
    __syncthreads();
    {
        const int e = F.tid & 15; int tot = 0, base = 0;
#pragma unroll
        for (int j = 0; j < 8; ++j) { const int b = (F.tid >> 4) + 32 * j; const int c = (b < F.G) ? F_blk_cnt(F)[b * 16 + e] : 0; tot += c; base += (b < F.bx) ? c : 0; }
        tot += __shfl_xor(tot, 16); tot += __shfl_xor(tot, 32); base += __shfl_xor(base, 16); base += __shfl_xor(base, 32);
        if (F.lane < 16) { __hip_atomic_fetch_add(ctl + LC_TOT / 4 + e, tot, __ATOMIC_RELAXED, __HIP_MEMORY_SCOPE_WORKGROUP); __hip_atomic_fetch_add(ctl + LC_BASE / 4 + e, base, __ATOMIC_RELAXED, __HIP_MEMORY_SCOPE_WORKGROUP); }
    }
    __syncthreads();
    if (F.tid == 0) { int acc = 0; for (int e = 0; e < 16; ++e) { ctl[LC_SEG / 4 + e] = acc * 256; ctl[LC_TS / 4 + e] = acc; acc += (ctl[LC_TOT / 4 + e] + 255) >> 8; } ctl[LC_TS / 4 + 16] = acc; }
    __syncthreads();
}

DI void perm_phase(Frame& F) {
    moe_tables(F);
    const LAS int* ctl = (const LAS int*)(F.lds + LDSCTL_OFF);
    const int tw = F.bx * 64 + F.wave * 8;
    int pos = 0;
    if (F.lane < 16) { const int idx = 2 * tw + F.lane; const int e = F_tok_e(F)[idx], r = F_tok_rank(F)[idx]; pos = ctl[LC_SEG / 4 + e] + ctl[LC_BASE / 4 + e] + r; F_tok_pos(F)[idx] = pos; }
    u32x4 va[8], vb[8];
#pragma unroll
    for (int i = 0; i < 8; ++i) { const u32x4* s = (const u32x4*)(F_H(F) + (size_t)(tw + i) * D); va[i] = s[F.lane]; vb[i] = s[F.lane + 64]; }
#pragma unroll
    for (int i = 0; i < 8; ++i)
#pragma unroll
        for (int k = 0; k < 2; ++k) { const int p = __builtin_amdgcn_readlane(pos, 2 * i + k); u32x4* d = (u32x4*)(F_HPERM(F) + (size_t)p * D); d[F.lane] = va[i]; d[F.lane + 64] = vb[i]; }
}

#define MFMA32(a, b, c) __builtin_amdgcn_mfma_f32_32x32x16_bf16((a), (b), (c), 0, 0, 0)
DI int crow(int i, int h) { return (i & 3) + 8 * (i >> 2) + 4 * h; }
DI bf16x8 pack8(const f32x16& x, int s) { u32x4 p; p.x = pk2(x[8 * s], x[8 * s + 1]); p.y = pk2(x[8 * s + 2], x[8 * s + 3]); p.z = pk2(x[8 * s + 4], x[8 * s + 5]); p.w = pk2(x[8 * s + 6], x[8 * s + 7]); return __builtin_bit_cast(bf16x8, p); }
DI s16x4 tr_read(const LAS unsigned char* p) { return __builtin_bit_cast(s16x4, __builtin_amdgcn_ds_read_tr16_b64_v4i16((LAS v4i16_t*)p)); }
constexpr int VP = 144;
DI bf16x8 vfrag(const LAS unsigned char* vlane, int off) { const s16x4 lo = tr_read(vlane + off), hi = tr_read(vlane + off + 8 * VP); return __builtin_shufflevector(lo, hi, 0, 1, 2, 3, 4, 5, 6, 7); }
DI void pv_accum(f32x16 (&oT)[2], const LAS unsigned char* vlane, const bf16x8 (&pp)[2][2]) {
#pragma unroll
    for (int blk = 0; blk < 2; ++blk)
#pragma unroll
        for (int s = 0; s < 2; ++s)
#pragma unroll
            for (int db = 0; db < 2; ++db) oT[db] = MFMA32(vfrag(vlane, (32 * blk + 16 * s) * VP + db * 64), pp[blk][s], oT[db]);
}
DI void softmax_tile(const f32x16& s0, const f32x16& s1, float& mrun, float& lrun, f32x16 (&oT)[2], bf16x8 (&pp)[2][2]) {
    float mx = fmaxf(s0[0], s1[0]);
#pragma unroll
    for (int i = 1; i < 16; ++i) mx = fmaxf(mx, fmaxf(s0[i], s1[i]));
    mx = fmaxf(mx, __shfl_xor(mx, 32));
    const float mnew = fmaxf(mrun, mx), alpha = fexp2(mrun - mnew);
    mrun = mnew;
    f32x16 p0, p1; float rs = 0.f;
#pragma unroll
    for (int i = 0; i < 16; ++i) { p0[i] = fexp2(s0[i] - mnew); p1[i] = fexp2(s1[i] - mnew); rs += p0[i] + p1[i]; }
    lrun = lrun * alpha + rs;
#pragma unroll
    for (int i = 0; i < 16; ++i) { oT[0][i] *= alpha; oT[1][i] *= alpha; }
    pp[0][0] = pack8(p0, 0); pp[0][1] = pack8(p0, 1); pp[1][0] = pack8(p1, 0); pp[1][1] = pack8(p1, 1);
}
DI void store_oT(bf16* orow, const f32x16 (&oT)[2], float sc, int h) {
#pragma unroll
    for (int db = 0; db < 2; ++db)
#pragma unroll
        for (int gq = 0; gq < 4; ++gq) { u32x2 w; w.x = pk2(oT[db][4 * gq] * sc, oT[db][4 * gq + 1] * sc); w.y = pk2(oT[db][4 * gq + 2] * sc, oT[db][4 * gq + 3] * sc);
            *(u32x2*)(orow + 32 * db + 8 * gq + 4 * h) = w; }
}

constexpr int SB_KP = 144, SB_TILE = 64 * SB_KP, SB_BUF = 2 * SB_TILE;
DI void sb_unit(Frame& F, int b, int hd, int qb) {
    const int lane = F.lane, r32 = lane & 31, h = lane >> 5, wave = F.wave;
    const int q0w = qb * 256 + wave * 32, qpos = q0w + r32;
    const size_t rowbase = (size_t)b * SEQ;
    const bf16* P = F_PROJ(F);
    bf16x8 qf[4];
#pragma unroll
    for (int s = 0; s < 4; ++s) qf[s] = *(const bf16x8*)(P + (rowbase + qpos) * NPROJ + PJ_SB + hd * 64 + 16 * s + 8 * h);
    bf16x8 tri[2], ones;
#pragma unroll
    for (int s = 0; s < 2; ++s)
#pragma unroll
        for (int j = 0; j < 8; ++j) tri[s][j] = ((16 * s + 8 * (j >> 2) + 4 * h + (j & 3)) > r32) ? (short)0x3F80 : (short)0;
#pragma unroll
    for (int j = 0; j < 8; ++j) ones[j] = (short)0x3F80;
    f32x16 oT[2], carry;
#pragma unroll
    for (int i = 0; i < 16; ++i) { oT[0][i] = 0.f; oT[1][i] = 0.f; carry[i] = 0.f; }
    const int NT = 4 * (qb + 1);
    const int srow = F.tid >> 3, sch = F.tid & 7;
    const bf16* kg = P + (rowbase + srow) * NPROJ + PJ_SB + 256 + hd * 64 + sch * 8;
    u32x4 kreg = *(const u32x4*)(kg + (size_t)(NT - 1) * 64 * NPROJ), vreg = *(const u32x4*)(kg + (size_t)(NT - 1) * 64 * NPROJ + 256);
    const int ldst = srow * SB_KP + sch * 16;
    const int klane = r32 * SB_KP + 16 * h;
    const int vlane_off = (4 * h + ((lane & 15) >> 2)) * VP + ((lane >> 4) & 1) * 32 + (lane & 3) * 8;
    for (int it = 0; it < NT; ++it) {
        const int kt = NT - 1 - it;
        LAS unsigned char* Kb = F.lds + (it & 1) * SB_BUF; LAS unsigned char* Vb = Kb + SB_TILE;
        *(LAS u32x4*)(Kb + ldst) = kreg; *(LAS u32x4*)(Vb + ldst) = vreg;
        __syncthreads();
        if (it + 1 < NT) { kreg = *(const u32x4*)(kg + (size_t)(kt - 1) * 64 * NPROJ); vreg = *(const u32x4*)(kg + (size_t)(kt - 1) * 64 * NPROJ + 256); }
        if (kt * 64 < q0w + 31) {
            f32x16 st0, st1;
#pragma unroll
            for (int i = 0; i < 16; ++i) { st0[i] = 0.f; st1[i] = 0.f; }
#pragma unroll
            for (int s = 0; s < 4; ++s) {
                const bf16x8 k0 = *(const LAS bf16x8*)(Kb + klane + 32 * s), k1 = *(const LAS bf16x8*)(Kb + klane + 32 * SB_KP + 32 * s);
                st0 = MFMA32(k0, qf[s], st0); st1 = MFMA32(k1, qf[s], st1);
            }
            f32x16 sp0, sp1;
            const int kb0 = kt * 64 + 4 * h;
#pragma unroll
            for (int i = 0; i < 16; ++i) {
                const int key0 = kb0 + (i & 3) + 8 * (i >> 2);
                st0[i] = fminf(st0[i], 126.f); st1[i] = fminf(st1[i], 126.f);
                const float a0 = flog2(1.0f + fexp2(st0[i])), a1 = flog2(1.0f + fexp2(st1[i]));
                sp0[i] = (key0 < qpos) ? a0 : 0.f; sp1[i] = (key0 + 32 < qpos) ? a1 : 0.f;
            }
            const bf16x8 s00 = pack8(sp0, 0), s01 = pack8(sp0, 1), s10 = pack8(sp1, 0), s11 = pack8(sp1, 1);
            f32x16 t1 = MFMA32(ones, s10, carry); t1 = MFMA32(ones, s11, t1);
            f32x16 y1 = MFMA32(tri[0], s10, carry); y1 = MFMA32(tri[1], s11, y1);
            f32x16 y0 = MFMA32(tri[0], s00, t1); y0 = MFMA32(tri[1], s01, y0);
            carry = MFMA32(ones, s00, t1); carry = MFMA32(ones, s01, carry);
            f32x16 w0, w1;
#pragma unroll
            for (int i = 0; i < 16; ++i) {
                const int key0 = kb0 + (i & 3) + 8 * (i >> 2);
                const float e0 = fexp2(st0[i] - sp0[i] - y0[i]), e1 = fexp2(st1[i] - sp1[i] - y1[i]);
                w0[i] = (key0 < qpos) ? e0 : 0.f; w1[i] = (key0 + 32 < qpos) ? e1 : 0.f;
            }
            bf16x8 pp[2][2]; pp[0][0] = pack8(w0, 0); pp[0][1] = pack8(w0, 1); pp[1][0] = pack8(w1, 0); pp[1][1] = pack8(w1, 1);
            pv_accum(oT, Vb + vlane_off, pp);
        }
    }
    store_oT(F_OBR(F) + (rowbase + qpos) * 768 + hd * 64, oT, 1.0f, h);
}

constexpr int ML_KP = 208, ML_KT = 64 * ML_KP, ML_BUF = ML_KT + 64 * VP;
DI void mla_unit(Frame& F, int b, int hd, int qb) {
    const int lane = F.lane, r32 = lane & 31, h = lane >> 5, wave = F.wave;
    const int q0w = qb * 256 + wave * 32, qpos = q0w + r32;
    const size_t rowbase = (size_t)b * SEQ;
    const bf16* MQp = F_MQ(F); const bf16* P = F_PROJ(F);
    bf16x8 qf[6];
#pragma unroll
    for (int s = 0; s < 6; ++s) qf[s] = *(const bf16x8*)(MQp + (rowbase + qpos) * D + hd * 96 + 16 * s + 8 * h);
    f32x16 oT[2];
#pragma unroll
    for (int i = 0; i < 16; ++i) { oT[0][i] = 0.f; oT[1][i] = 0.f; }
    float mrun = -1e30f, lrun = 0.f;
    const int NT = 4 * (qb + 1);
    const int i0 = F.tid, i1 = F.tid + 512;
    const int r0 = i0 / 12, c0 = i0 % 12, r1 = i1 / 12, c1 = i1 % 12; const bool has1 = i1 < 768;
    const bf16* kg0 = (c0 < 8) ? MQp + (rowbase + r0) * D + 384 + hd * 128 + c0 * 8 : P + (rowbase + r0) * NPROJ + PJ_KR + (c0 - 8) * 8;
    const size_t ks0 = (c0 < 8) ? (size_t)64 * D : (size_t)64 * NPROJ;
    const bf16* kg1 = (c1 < 8) ? MQp + (rowbase + (has1 ? r1 : 0)) * D + 384 + hd * 128 + c1 * 8 : P + (rowbase + (has1 ? r1 : 0)) * NPROJ + PJ_KR + (c1 - 8) * 8;
    const size_t ks1 = (c1 < 8) ? (size_t)64 * D : (size_t)64 * NPROJ;
    const int vr = F.tid >> 3, vc = F.tid & 7;
    const bf16* vg = MQp + (rowbase + vr) * D + 384 + hd * 128 + 64 + vc * 8;
    u32x4 kreg0 = *(const u32x4*)kg0, kreg1 = (u32x4){0u, 0u, 0u, 0u}, vreg = *(const u32x4*)vg;
    if (has1) kreg1 = *(const u32x4*)kg1;
    const int kd0 = r0 * ML_KP + c0 * 16, kd1 = r1 * ML_KP + c1 * 16, vd = vr * VP + vc * 16;
    const int klane = r32 * ML_KP + 16 * h;
    const int vlane_off = (4 * h + ((lane & 15) >> 2)) * VP + ((lane >> 4) & 1) * 32 + (lane & 3) * 8;
    for (int kt = 0; kt < NT; ++kt) {
        LAS unsigned char* Kb = F.lds + (kt & 1) * ML_BUF; LAS unsigned char* Vb = Kb + ML_KT;
        *(LAS u32x4*)(Kb + kd0) = kreg0; if (has1) *(LAS u32x4*)(Kb + kd1) = kreg1; *(LAS u32x4*)(Vb + vd) = vreg;
        __syncthreads();
        if (kt + 1 < NT) { kreg0 = *(const u32x4*)(kg0 + (size_t)(kt + 1) * ks0); if (has1) kreg1 = *(const u32x4*)(kg1 + (size_t)(kt + 1) * ks1); vreg = *(const u32x4*)(vg + (size_t)(kt + 1) * 64 * D); }
        if (kt * 64 <= q0w + 31) {
            f32x16 st0, st1;
#pragma unroll
            for (int i = 0; i < 16; ++i) { st0[i] = 0.f; st1[i] = 0.f; }
#pragma unroll
            for (int s = 0; s < 6; ++s) {
                const bf16x8 k0 = *(const LAS bf16x8*)(Kb + klane + 32 * s), k1 = *(const LAS bf16x8*)(Kb + klane + 32 * ML_KP + 32 * s);
                st0 = MFMA32(k0, qf[s], st0); st1 = MFMA32(k1, qf[s], st1);
            }
            if (kt * 64 + 63 > q0w) {
                const int kb0 = kt * 64 + 4 * h;
#pragma unroll
                for (int i = 0; i < 16; ++i) { const int key0 = kb0 + (i & 3) + 8 * (i >> 2); if (key0 > qpos) st0[i] = -INFINITY; if (key0 + 32 > qpos) st1[i] = -INFINITY; }
            }
            bf16x8 pp[2][2];
            softmax_tile(st0, st1, mrun, lrun, oT, pp);
            pv_accum(oT, Vb + vlane_off, pp);
        }
    }
    const float ltot = lrun + __shfl_xor(lrun, 32);
    store_oT(F_OBR(F) + (rowbase + qpos) * 768 + 256 + hd * 64, oT, 1.0f / ltot, h);
}

template <int GI>
DI void dil_group(Frame& F, int b, int hd, int P0, int r32, int h, int lane, LAS unsigned char* Vw, float& mrun, float& lrun, f32x16 (&oT)[2]) {
    constexpr int SH = GI == 0 ? 0 : (GI == 1 ? 2 : 4), R = 1 << SH, STEP = 16 >> SH, NTILE = GI == 0 ? 10 : (GI == 1 ? 4 : 3), NSUB = SEQ >> SH;
    const bf16* P = F_PROJ(F);
    const size_t rowbase = (size_t)b * SEQ;
    const int rc = P0 & (R - 1), i0 = P0 >> SH, iq = i0 + STEP * r32, start = i0 - 128;
    const int qcol = PJ_DIL + GI * 768 + hd * 64, kcol = qcol + 256, vcol = qcol + 512;
    bf16x8 qf[4];
#pragma unroll
    for (int s = 0; s < 4; ++s) qf[s] = *(const bf16x8*)(P + (rowbase + P0 + 16 * r32) * NPROJ + qcol + 16 * s + 8 * h);
    const int vlane_off = (4 * h + ((lane & 15) >> 2)) * VP + ((lane >> 4) & 1) * 32 + (lane & 3) * 8;
    for (int kt = 0; kt < NTILE; ++kt) {
        const int kidx0 = start + 64 * kt;
        bf16x8 kf[2][4];
#pragma unroll
        for (int blk = 0; blk < 2; ++blk) {
            int kid = kidx0 + 32 * blk + r32; kid = kid < 0 ? 0 : (kid > NSUB - 1 ? NSUB - 1 : kid);
            const bf16* kp = P + (rowbase + rc + ((size_t)kid << SH)) * NPROJ + kcol + 8 * h;
#pragma unroll
            for (int s = 0; s < 4; ++s) kf[blk][s] = *(const bf16x8*)(kp + 16 * s);
        }
        u32x4 vv[8];
#pragma unroll
        for (int i = 0; i < 8; ++i) {
            int kid = kidx0 + (lane >> 3) + 8 * i; kid = kid < 0 ? 0 : (kid > NSUB - 1 ? NSUB - 1 : kid);
            vv[i] = *(const u32x4*)(P + (rowbase + rc + ((size_t)kid << SH)) * NPROJ + vcol + (lane & 7) * 8);
        }
        asm volatile("" ::: "memory");
#pragma unroll
        for (int i = 0; i < 8; ++i) *(LAS u32x4*)(Vw + ((lane >> 3) + 8 * i) * VP + (lane & 7) * 16) = vv[i];
        LDS_WAIT();
        f32x16 st0, st1;
#pragma unroll
        for (int i = 0; i < 16; ++i) { st0[i] = 0.f; st1[i] = 0.f; }
#pragma unroll
        for (int s = 0; s < 4; ++s) { st0 = MFMA32(kf[0][s], qf[s], st0); st1 = MFMA32(kf[1][s], qf[s], st1); }
#pragma unroll
        for (int i = 0; i < 16; ++i) {
            const int k0 = kidx0 + 4 * h + (i & 3) + 8 * (i >> 2), k1 = k0 + 32;
            if (!(k0 >= 0 && k0 <= iq && k0 >= iq - 128)) st0[i] = -INFINITY;
            if (!(k1 >= 0 && k1 <= iq && k1 >= iq - 128)) st1[i] = -INFINITY;
        }
        bf16x8 pp[2][2];
        softmax_tile(st0, st1, mrun, lrun, oT, pp);
        pv_accum(oT, Vw + vlane_off, pp);
        LDS_WAIT();
    }
}
DI void dil_unit(Frame& F, int b, int hd, int span, int half) {
    const int lane = F.lane, r32 = lane & 31, h = lane >> 5;
    const int P0 = span * 512 + 8 * half + F.wave;
    LAS unsigned char* Vw = F.lds + F.wave * (64 * VP);
    f32x16 oT[2];
#pragma unroll
    for (int i = 0; i < 16; ++i) { oT[0][i] = 0.f; oT[1][i] = 0.f; }
    float mrun = -1e30f, lrun = 0.f;
    dil_group<0>(F, b, hd, P0, r32, h, lane, Vw, mrun, lrun, oT);
    dil_group<1>(F, b, hd, P0, r32, h, lane, Vw, mrun, lrun, oT);
    dil_group<2>(F, b, hd, P0, r32, h, lane, Vw, mrun, lrun, oT);
    const float ltot = lrun + __shfl_xor(lrun, 32);
    store_oT(F_OBR(F) + ((size_t)b * SEQ + P0 + 16 * r32) * 768 + 512 + hd * 64, oT, 1.0f / ltot, h);
}

DI void attn_phase(Frame& F, int l) {
    unsigned* ctr = F_ctl(F) + CW_Q + 64 * l;
    volatile LAS unsigned* slot = (volatile LAS unsigned*)(F.lds + LDSCTL_OFF + LC_Q);
    constexpr unsigned NU = 768;
    for (;;) {
        if (F.tid == 0) *slot = __hip_atomic_fetch_add(ctr, 1u, __ATOMIC_RELAXED, __HIP_MEMORY_SCOPE_AGENT);
        __syncthreads();
        const unsigned u = (unsigned)__builtin_amdgcn_readfirstlane((int)*slot);
        __syncthreads();
        if (u >= NU) break;
        if (u < 512u) {
            const int qb = 31 - (int)(u >> 4), r = (int)(u & 15u), bh = r & 7, b = bh >> 2, hd = bh & 3;
            if (r < 8) sb_unit(F, b, hd, qb); else mla_unit(F, b, hd, qb);
        } else {
            const int j = (int)u - 512; dil_unit(F, j >> 7, (j >> 5) & 3, (j & 31) >> 1, j & 1);
        }
    }
}

constexpr int N_PHASES = 41;

__global__ void __launch_bounds__(512, 2) fwd_kernel(Args a) {
    extern __shared__ __attribute__((aligned(16))) unsigned char lds_raw[];
    {
        LAS unsigned* lc = (LAS unsigned*)((LAS unsigned char*)lds_raw + LDSCTL_OFF);
        for (int u = threadIdx.x; u < (LDS_BYTES - LDSCTL_OFF) / 4; u += 512) lc[u] = 0u;
    }
    __syncthreads();
    const int lo = a.ph_lo, hi = a.ph_hi;
    unsigned* const barw = (unsigned*)(a.ws + WS_CTL) + CW_BAR;
    XcdBarrier bar; bar.bar = barw; bar.x = 0; bar.st = nullptr;
    if (hi - lo > 1) bar = xcd_barrier_post(barw, (volatile LAS unsigned*)((LAS unsigned char*)lds_raw + LDSCTL_OFF + LC_XB));
#define IN(k) (lo <= (k) && (k) < hi)
#define SEAM(k) do { if (IN(k) && IN((k) + 1)) xcd_barrier(bar); } while (0)
#ifndef DUP_PHASE
#define DUP_PHASE -1
#endif
#define DUP(k) if (DUP_PHASE == (k) && IN(pb + (k)) && (xcd_barrier(bar), true))

    for (int l = 0; l < NLAYER; ++l) {
        const int pb = 10 * l;
        if (IN(pb + 0)) { Frame F = mkframe(); if (l == 0) pre_tables(F); conv_phase(F, l); norm_phase<false>(F, l, F_g_mix(F) + l * 1024); }
        SEAM(pb + 0);
        if (IN(pb + 1)) {
            Frame F = mkframe();
            pg8::Gemm g{F_H(F), F_Win_t(F), 1024, 1024, 1024}; pg8::StaticOrder S; S.init(T, NPROJ, F.G, F.bx);
            EpiInproj E{F_PROJ(F), (const f32x4*)F_cs64(F), (const f32x4*)F_cs32(F)};
            pg8::gemm_phase<EpiInproj, pg8::StaticOrder, true>(F.lds, F.tid, g, S, E);
        }
        DUP(1) {
            Frame F = mkframe();
            pg8::Gemm g{F_H(F), F_Win_t(F), 1024, 1024, 1024}; pg8::StaticOrder S; S.init(T, NPROJ, F.G, F.bx);
            EpiInproj E{F_PROJ(F), (const f32x4*)F_cs64(F), (const f32x4*)F_cs32(F)};
            pg8::gemm_phase<EpiInproj, pg8::StaticOrder, true>(F.lds, F.tid, g, S, E);
        }
        SEAM(pb + 1);
        if (IN(pb + 2)) {
            Frame F = mkframe();
            pg8::Gemm g{F_PROJ(F) + PJ_MLA, F_Wup_t(F), NPROJ, 512, 512}; pg8::StaticOrder S; S.init(T, 1024, F.G, F.bx);
            EpiMlaUp E{F_MQ(F), F_PROJ(F), (const f32x4*)F_cs32(F)};
            pg8::gemm_phase<EpiMlaUp, pg8::StaticOrder, false>(F.lds, F.tid, g, S, E);
        }
        SEAM(pb + 2);
        if (IN(pb + 3)) { Frame F = mkframe(); attn_phase(F, l); }
        DUP(3) { Frame F = mkframe(); attn_phase(F, l + 4); }
        SEAM(pb + 3);
        if (IN(pb + 4)) {
            Frame F = mkframe();
            pg8::Gemm g{F_OBR(F), F_Wb_t(F), 768, 256, 256}; MergeOrder S{F.G, F.vcu};
            EpiMerge E{F_H(F), F_PROJ(F)};
            pg8::gemm_phase<EpiMerge, MergeOrder, false>(F.lds, F.tid, g, S, E);
        }
        SEAM(pb + 4);
        if (IN(pb + 5)) {
            Frame F = mkframe();
            pg8::Gemm g{F_H(F), F_Wout_t(F), 1024, 1024, 1024}; pg8::StaticOrder S; S.init(T, 1024, F.G, F.bx);
            EpiResid E{F.out};
            pg8::gemm_phase<EpiResid, pg8::StaticOrder, false>(F.lds, F.tid, g, S, E);
        }
        SEAM(pb + 5);
        if (IN(pb + 6)) { Frame F = mkframe(); route_phase(F, l); }
        SEAM(pb + 6);
        if (IN(pb + 7)) { Frame F = mkframe(); perm_phase(F); }
        SEAM(pb + 7);
        if (IN(pb + 8)) {
            Frame F = mkframe();
            moe_tables(F);
            pg8::Gemm g{F_HPERM(F), F_W1_t(F), 1024, 1024, 1024}; MoeOrder S{(const LAS int*)(F.lds + LDSCTL_OFF + LC_TS), 2, F.G, F.vcu};
            EpiSwiglu E{F_HID(F)};
            pg8::gemm_phase<EpiSwiglu, MoeOrder, true>(F.lds, F.tid, g, S, E);
        }
        SEAM(pb + 8);
        if (IN(pb + 9)) {
            Frame F = mkframe();
            moe_tables(F);
            pg8::Gemm g{F_HID(F), F_W2_t(F), 256, 256, 256}; MoeOrder S{(const LAS int*)(F.lds + LDSCTL_OFF + LC_TS), 4, F.G, F.vcu};
            EpiY E{F_YBUF(F)};
            pg8::gemm_phase<EpiY, MoeOrder, true>(F.lds, F.tid, g, S, E);
        }
        SEAM(pb + 9);
    }
    if (IN(40)) { Frame F = mkframe(); norm_phase<true>(F, NLAYER, F_g_final(F)); }
#undef IN
#undef SEAM
}

extern "C" void kernel_launch(void* const* d_in, const int* in_sizes, int n_in, void* d_out, int out_size, void* d_ws, size_t ws_size, hipStream_t stream) {
    static int grid = 0;
    if (grid == 0) {
        if (n_in != 19 || out_size != T * D || ws_size < WS_END) { fprintf(stderr, "kernel_launch: unexpected problem (n_in %d, out %d, ws %zu < %zu)\n", n_in, out_size, ws_size, (size_t)WS_END); grid = -1; return; }
        if (hipFuncSetAttribute((const void*)fwd_kernel, hipFuncAttributeMaxDynamicSharedMemorySize, LDS_BYTES) != hipSuccess) { fprintf(stderr, "kernel_launch: hipFuncSetAttribute failed\n"); grid = -1; return; }
        int per_cu = 0;
        if (hipOccupancyMaxActiveBlocksPerMultiprocessor(&per_cu, (const void*)fwd_kernel, 512, LDS_BYTES) != hipSuccess || per_cu < 1) fprintf(stderr, "kernel_launch: occupancy query reports %d blocks per CU\n", per_cu);
        (void)hipGetLastError();
        grid = 256;
    }
    if (grid < 0) return;
    (void)in_sizes;
    if (hipMemsetAsync((char*)d_ws + WS_CTL, 0, CTL_ZERO_BYTES, stream) != hipSuccess) return;
    Args a{};
    for (int i = 0; i < 19; ++i) a.in[i] = d_in[i];
    a.out = (float*)d_out; a.ws = (unsigned char*)d_ws;
#if MK_PER_PHASE
    for (int p = 0; p < N_PHASES; ++p) { a.ph_lo = p; a.ph_hi = p + 1; hipLaunchKernelGGL(fwd_kernel, dim3(grid), dim3(512), LDS_BYTES, stream, a); }
#else
    a.ph_lo = 0; a.ph_hi = N_PHASES;
    hipLaunchKernelGGL(fwd_kernel, dim3(grid), dim3(512), LDS_BYTES, stream, a);
#endif
}
```

```cpp
#include <hip/hip_runtime.h>
#include <cstdio>
#include <cstdint>

#ifndef MK_PER_PHASE
#define MK_PER_PHASE 0
#endif

#define LAS __attribute__((address_space(3)))
#define GAS __attribute__((address_space(1)))
typedef unsigned short bf16;
typedef short bf16x8 __attribute__((ext_vector_type(8)));
typedef short s16x4 __attribute__((ext_vector_type(4)));
typedef float f32x2 __attribute__((ext_vector_type(2)));
typedef float f32x4 __attribute__((ext_vector_type(4)));
typedef float f32x16 __attribute__((ext_vector_type(16)));
typedef unsigned u32x2 __attribute__((ext_vector_type(2)));
typedef unsigned u32x4 __attribute__((ext_vector_type(4)));
typedef __bf16 bf2_t __attribute__((ext_vector_type(2)));
typedef short v4i16_t __attribute__((ext_vector_type(4)));

#define DI __device__ __forceinline__
DI unsigned pk2(float a, float b) { f32x2 v = {a, b}; return __builtin_bit_cast(unsigned, __builtin_convertvector(v, bf2_t)); }
DI float bflo(unsigned u) { return __uint_as_float(u << 16); }
DI float bfhi(unsigned u) { return __uint_as_float(u & 0xffff0000u); }
DI float fexp2(float x) { return __builtin_amdgcn_exp2f(x); }
DI float flog2(float x) { return __builtin_amdgcn_logf(x); }
DI float frcp(float x) { return __builtin_amdgcn_rcpf(x); }

constexpr int T = 16384, D = 1024, SEQ = 8192, NLAYER = 4;
constexpr int NPROJ = 6656;
constexpr int PJ_SB = 0, PJ_MLA = 768, PJ_KR = 1152, PJ_DIL = 1280, PJ_GATE = 3584;
constexpr int INC = 6560;
constexpr float EPS = 1e-6f;
constexpr float LOG2E = 1.4426950408889634f;
constexpr float C_SB = 0.125f * LOG2E;
constexpr float C_MLA = 0.10206207261596577f * LOG2E;
constexpr int MROWS = 36864;

namespace pg8 {
constexpr int BM = 256, BK = 64, HALF = 128, HTB = HALF * BK * 2, STAGE_BYTES = 8 * HTB, NXCD = 8, WGM = 8;
__host__ __device__ __forceinline__ int lds_byte(int r, int c) { const int st = (r >> 4) * 2 + (c >> 5), rr = r & 15, cc = c & 31, ob = rr * 64 + cc * 2; return st * 1024 + (ob ^ (((ob >> 9) & 1) << 5)); }
__host__ __device__ __forceinline__ void stage_rc(int b, int& R, int& C) { const int st = b / 1024, sb = b % 1024, swz = sb ^ (((sb >> 9) & 1) << 5); R = (st >> 1) * 16 + swz / 64; C = (st & 1) * 32 + (swz % 64) / 2; }
__host__ __device__ __forceinline__ int perm32(int rho) { const int n = rho >> 4, i = rho & 15; return 8 * (i >> 2) + 4 * n + (i & 3); }

struct Unit { int pm, pn, ka; };
struct Gemm { const bf16* A; const bf16* Bt; int lda, ldb, K; };

struct StaticOrder {
    int nM, nN, nwg, G, c;
    __device__ void init(int M, int N, int G_, int c_) { nM = M / BM; nN = N / BM; nwg = nM * nN; G = G_; c = c_; }
    __device__ bool next(int i, Unit& u) const {
        const long L = (long)i * G + c; if (L >= nwg) return false;
        int wgid = (int)L; { const int q = nwg / NXCD, r = nwg % NXCD, xcd = wgid % NXCD, off = wgid / NXCD; wgid = (xcd < r ? xcd * (q + 1) : r * (q + 1) + (xcd - r) * q) + off; }
        const int nig = WGM * nN, gid = wgid / nig, fm = gid * WGM, gsz = (nM - fm) < WGM ? (nM - fm) : WGM;
        u.pm = fm + ((wgid % nig) % gsz); u.pn = (wgid % nig) / gsz; u.ka = 0; return true;
    }
};

template <class Epi, class Sched, bool ALIGN_EPI>
__device__ __forceinline__ void gemm_phase(LAS unsigned char* lds, const int tid, const Gemm g, const Sched& S, const Epi& E) {
    const int wid = __builtin_amdgcn_readfirstlane(tid >> 6), lane = tid & 63, wr = wid >> 2, wc = wid & 3, fr = lane & 15, fq = lane >> 4;
    const int K = g.K, nt = K / BK;
    unsigned voffA[2], voffB[2];
#pragma unroll
    for (int i = 0; i < 2; ++i) { int R, C; stage_rc(tid * 16 + i * 8192, R, C); const int Rb = Epi::PERM ? ((R & ~31) + perm32(R & 31)) : R;
        voffA[i] = (unsigned)(R * g.lda + C) * 2u; voffB[i] = (unsigned)(Rb * g.ldb + C) * 2u; }
    const size_t kstep = (size_t)(BK * 2);
    const size_t hstepA = (size_t)HALF * g.lda * 2, hstepB = (size_t)HALF * g.ldb * 2;
    const size_t tstepA = 2 * hstepA, tstepB = 2 * hstepB;
    const unsigned ldsw = (unsigned)wid * 1024u;
    const int aoff = lds_byte(wr * 64 + fr, fq * 8), boff = lds_byte(wc * 32 + fr, fq * 8);
#define PG8_SA(b, h) (((b) * 2 + (h)) * HTB)
#define PG8_SB(b, h) ((4 + (b) * 2 + (h)) * HTB)
#define PG8_STAGE(bufoff, gbase, voff) do { _Pragma("unroll") for (int _i = 0; _i < 2; ++_i) \
        __builtin_amdgcn_global_load_lds((const unsigned*)((const char*)(gbase) + (voff)[_i]), (LAS unsigned*)(lds + (bufoff) + ldsw + _i * 8192), 16, 0, 0); } while (0)
#define PG8_LDA(dst, b, h) do { _Pragma("unroll") for (int m = 0; m < 4; ++m) _Pragma("unroll") for (int k = 0; k < 2; ++k) dst[m][k] = *(const LAS bf16x8*)(lds + PG8_SA(b, h) + aoff + m * 2048 + k * 1024); } while (0)
#define PG8_LDB(dst, b, h) do { _Pragma("unroll") for (int n = 0; n < 2; ++n) _Pragma("unroll") for (int k = 0; k < 2; ++k) dst[n][k] = *(const LAS bf16x8*)(lds + PG8_SB(b, h) + boff + n * 2048 + k * 1024); } while (0)
#define PG8_MMA(ai, bj, At, Bt) do { __builtin_amdgcn_s_setprio(1); _Pragma("unroll") for (int m = 0; m < 4; ++m) _Pragma("unroll") for (int n = 0; n < 2; ++n) _Pragma("unroll") for (int k = 0; k < 2; ++k) \
        acc[ai][bj][m][n] = __builtin_amdgcn_mfma_f32_16x16x32_bf16(Bt[n][k], At[m][k], acc[ai][bj][m][n], 0, 0, 0); __builtin_amdgcn_s_setprio(0); } while (0)
#define PG8_WAIT_V(n) asm volatile("s_waitcnt vmcnt(" #n ")" ::: "memory")
#define PG8_WAIT_L(n) asm volatile("s_waitcnt lgkmcnt(" #n ")" ::: "memory")
#define PG8_BAR __builtin_amdgcn_s_barrier()
#define PG8_SCHED __builtin_amdgcn_sched_barrier(0)
    Unit cur, nxt; int ui = 0;
    if (!S.next(0, cur)) return;
    f32x4 acc[2][2][4][2];
#pragma unroll
    for (int a = 0; a < 2; ++a)
#pragma unroll
        for (int b = 0; b < 2; ++b)
#pragma unroll
            for (int m = 0; m < 4; ++m)
#pragma unroll
                for (int n = 0; n < 2; ++n) acc[a][b][m][n] = (f32x4){0.f, 0.f, 0.f, 0.f};
    bf16x8 At[4][2], B0[2][2], B1[2][2];
    const char* cA = (const char*)g.A + (size_t)cur.pm * tstepA + (size_t)cur.ka * 2; const char* cB = (const char*)g.Bt + (size_t)cur.pn * tstepB;
    PG8_STAGE(PG8_SB(0, 0), cB, voffB); PG8_STAGE(PG8_SB(0, 1), cB + hstepB, voffB); PG8_STAGE(PG8_SA(0, 0), cA, voffA); PG8_STAGE(PG8_SA(0, 1), cA + hstepA, voffA);
    if (wr == 1) PG8_BAR;
    PG8_WAIT_V(2); PG8_BAR;
    PG8_STAGE(PG8_SB(1, 0), cB + kstep, voffB); PG8_STAGE(PG8_SA(1, 0), cA + kstep, voffA); PG8_STAGE(PG8_SB(1, 1), cB + hstepB + kstep, voffB);
    PG8_WAIT_V(6); PG8_BAR;
    for (;;) {
        const bool has_next = S.next(ui + 1, nxt);
        const char* nA = has_next ? (const char*)g.A + (size_t)nxt.pm * tstepA + (size_t)nxt.ka * 2 : cA; const char* nB = has_next ? (const char*)g.Bt + (size_t)nxt.pn * tstepB : cB;
#pragma unroll 1
        for (int t = 0; t < nt; t += 2) {
            const bool last = (t == nt - 2);
            const char* a1 = cA + (size_t)(t + 1) * kstep;
            const char* a2 = last ? nA : cA + (size_t)(t + 2) * kstep; const char* b2 = last ? nB : cB + (size_t)(t + 2) * kstep;
            const char* a3 = a2 + kstep; const char* b3 = b2 + kstep;
            PG8_LDB(B0, 0, 0); PG8_LDB(B1, 0, 1); PG8_SCHED; PG8_LDA(At, 0, 0); PG8_STAGE(PG8_SA(1, 1), a1 + hstepA, voffA);
            PG8_WAIT_V(8); PG8_WAIT_L(0); PG8_BAR; PG8_MMA(0, 0, At, B0); PG8_MMA(0, 1, At, B1); PG8_BAR; PG8_SCHED;
            PG8_LDA(At, 0, 1); PG8_STAGE(PG8_SB(0, 0), b2, voffB); PG8_STAGE(PG8_SB(0, 1), b2 + hstepB, voffB); PG8_STAGE(PG8_SA(0, 0), a2, voffA);
            PG8_WAIT_V(8); PG8_WAIT_L(0); PG8_BAR; PG8_MMA(1, 0, At, B0); PG8_MMA(1, 1, At, B1); PG8_BAR; PG8_SCHED;
            PG8_LDB(B0, 1, 0); PG8_LDB(B1, 1, 1); PG8_SCHED; PG8_LDA(At, 1, 0); PG8_STAGE(PG8_SA(0, 1), a2 + hstepA, voffA);
            PG8_WAIT_V(8); PG8_WAIT_L(0); PG8_BAR; PG8_MMA(0, 0, At, B0); PG8_MMA(0, 1, At, B1); PG8_BAR; PG8_SCHED;
            PG8_LDA(At, 1, 1); PG8_STAGE(PG8_SB(1, 0), b3, voffB); PG8_STAGE(PG8_SB(1, 1), b3 + hstepB, voffB); PG8_STAGE(PG8_SA(1, 0), a3, voffA);
            PG8_WAIT_V(8); PG8_WAIT_L(0); PG8_BAR; PG8_MMA(1, 0, At, B0); PG8_MMA(1, 1, At, B1); PG8_BAR; PG8_SCHED;
        }
        if constexpr (ALIGN_EPI) { if (wr == 0) PG8_BAR; }
        E(acc, cur, wr, wc, fr, fq);
        if (!has_next) break;
        if (!E.keep(cur)) {
#pragma unroll
            for (int a = 0; a < 2; ++a)
#pragma unroll
                for (int b = 0; b < 2; ++b)
#pragma unroll
                    for (int m = 0; m < 4; ++m)
#pragma unroll
                        for (int n = 0; n < 2; ++n) acc[a][b][m][n] = (f32x4){0.f, 0.f, 0.f, 0.f};
        }
        cur = nxt; cA = nA; cB = nB; ++ui;
        if constexpr (ALIGN_EPI) { if (wr == 1) PG8_BAR; }
    }
    PG8_WAIT_V(0);
    if constexpr (!ALIGN_EPI) { if (wr == 0) PG8_BAR; }
    PG8_BAR;
#undef PG8_SA
#undef PG8_SB
#undef PG8_STAGE
#undef PG8_LDA
#undef PG8_LDB
#undef PG8_MMA
#undef PG8_WAIT_V
#undef PG8_WAIT_L
#undef PG8_BAR
#undef PG8_SCHED
}
}
using pg8::Unit;

constexpr size_t MiB = 1u << 20;
constexpr size_t WS_CTL = 0, CTL_ZERO_BYTES = 1 * MiB;
constexpr size_t WS_RT = 1 * MiB;
constexpr size_t RT_E = 0, RT_W = 131072, RT_RANK = 262144, RT_POS = 393216, RT_CNT = 524288, RT_SQ = 1048576, RT_SKV = 1310720;
constexpr size_t WS_CS64 = 4 * MiB, WS_CS32 = 8 * MiB;
constexpr size_t WS_WIN = 10 * MiB, WS_WUP = 23 * MiB, WS_WB = 24 * MiB, WS_WOUT = 26 * MiB, WS_W1 = 28 * MiB, WS_W2 = 44 * MiB;
constexpr size_t WS_H = 52 * MiB;
constexpr size_t WS_MQ = 84 * MiB;
constexpr size_t WS_OBR = 116 * MiB;
constexpr size_t WS_PROJ = 140 * MiB;
constexpr size_t WS_HPERM = 140 * MiB, WS_HID = 212 * MiB, WS_YBUF = 230 * MiB;
constexpr size_t WS_END = 348 * MiB;
static_assert(WS_WIN + (size_t)NPROJ * 1024 * 2 <= WS_WUP && WS_YBUF + (size_t)MROWS * 1024 * 2 <= WS_END && WS_HPERM + (size_t)MROWS * 1024 * 2 <= WS_HID && WS_HID + (size_t)MROWS * 256 * 2 <= WS_YBUF, "ws map");
static_assert(WS_PROJ + (size_t)T * NPROJ * 2 <= WS_END, "ws map 2");
constexpr int CW_BAR = 4096, CW_Q = 8192;

constexpr int RING_BYTES = 131072;
constexpr int LDSCTL_OFF = RING_BYTES;
constexpr int LC_XB = 0, LC_Q = 16, LC_TS = 64  , LC_TOT = 192  , LC_BASE = 256  , LC_SEG = 320  ;
constexpr int LDS_BYTES = 147456;

#define XB_TMO      128
#define XB_XCNT(j)  (256  + 64 * (j))
#define XB_XSUB(j)  (1280 + 64 * (j))
#define XB_XGEN(j)  (2304 + 64 * (j))
#define XB_TOP      3328
#define XB_TOPGEN   3392
#define XCD_BAR_WORDS 3456
#define XB_SPIN_CAP (1u << 18)
DI unsigned xb_ld(unsigned* p)              { return __hip_atomic_load(p, __ATOMIC_RELAXED, __HIP_MEMORY_SCOPE_AGENT); }
DI unsigned xb_add(unsigned* p, unsigned v) { return __hip_atomic_fetch_add(p, v, __ATOMIC_RELAXED, __HIP_MEMORY_SCOPE_AGENT); }
DI unsigned xb_xcc_id() { return (unsigned)__builtin_amdgcn_s_getreg((3 << 11) | 20) & 0xFu; }
#define XB_SPIN(cond, bar) do { unsigned _sp = 0; while (cond) { __builtin_amdgcn_s_sleep(1); \
    if ((++_sp & 255u) == 0u) { if (xb_ld(&(bar)[XB_TMO])) break; if (_sp > XB_SPIN_CAP) { atomicAdd(&(bar)[XB_TMO], 1u); break; } } } } while (0)
struct XcdBarrier { unsigned* bar; unsigned x; volatile LAS unsigned* st; };
DI XcdBarrier xcd_barrier_post(unsigned* bar, volatile LAS unsigned* st) {
    XcdBarrier b; b.bar = bar; b.x = xb_xcc_id(); b.st = st;
    if (threadIdx.x == 0) (void)xb_add(&bar[XB_XCNT(b.x)], 1u);
    return b;
}
DI void xcd_barrier_complete(unsigned* bar, unsigned x, unsigned& nloc, unsigned& nx) {
    const unsigned G = gridDim.x * gridDim.y * gridDim.z;
    unsigned sum, cnt, mine, sp = 0u;
    for (;;) {
        sum = 0u; cnt = 0u; mine = 0u;
#pragma unroll
        for (unsigned j = 0; j < 16; ++j) { const unsigned c = xb_ld(&bar[XB_XCNT(j)]); sum += c; cnt += (c > 0u) ? 1u : 0u; mine = (j == x) ? c : mine; }
        if (sum == G) break;
        __builtin_amdgcn_s_sleep(1);
        if ((++sp & 255u) == 0u) { if (xb_ld(&bar[XB_TMO])) break; if (sp > XB_SPIN_CAP) { atomicAdd(&bar[XB_TMO], 1u); break; } }
    }
    nloc = mine > 0u ? mine : 1u; nx = cnt > 0u ? cnt : 1u;
}
DI void xcd_barrier(const XcdBarrier& b) {
    asm volatile("s_waitcnt vmcnt(0)" ::: "memory");
    __syncthreads();
    if (threadIdx.x == 0) {
        unsigned* bar = b.bar;
        __builtin_amdgcn_s_waitcnt(0);
        unsigned nloc = b.st[0], nx = b.st[1];
        if (nloc == 0u) { xcd_barrier_complete(bar, b.x, nloc, nx); b.st[0] = nloc; b.st[1] = nx; }
        const unsigned old = xb_add(&bar[XB_XSUB(b.x)], 1u);
        const unsigned gen = old / nloc;
        if (old + 1u == (gen + 1u) * nloc) {
            __builtin_amdgcn_fence(__ATOMIC_RELEASE, "agent");
            asm volatile("s_waitcnt vmcnt(0)" ::: "memory");
            const unsigned og = xb_add(&bar[XB_TOP], 1u);
            const unsigned tg = og / nx;
            if (og + 1u == (tg + 1u) * nx) xb_add(&bar[XB_TOPGEN], 1u);
            else XB_SPIN(xb_ld(&bar[XB_TOPGEN]) == tg, bar);
            __builtin_amdgcn_fence(__ATOMIC_ACQUIRE, "agent");
            xb_add(&bar[XB_XGEN(b.x)], 1u);
            asm volatile("s_waitcnt vmcnt(0)" ::: "memory");
        } else {
            XB_SPIN(xb_ld(&bar[XB_XGEN(b.x)]) == gen, bar);
            __builtin_amdgcn_fence(__ATOMIC_ACQUIRE, "agent");
            asm volatile("s_waitcnt vmcnt(0)" ::: "memory");
        }
    }
    __syncthreads();
}

struct Args { const void* in[19]; float* out; unsigned char* ws; int ph_lo, ph_hi; };
struct Frame {
    LAS unsigned char* lds;
    unsigned char* ws; float* out;
    const __attribute__((address_space(4))) Args* ap;
    int tid, lane, wave, vcu, G, bx;
};
DI Frame mkframe() {
    extern __shared__ __attribute__((aligned(16))) unsigned char lds_raw[];
    Frame F;
    F.lds = (LAS unsigned char*)lds_raw;
    int t = threadIdx.x; asm volatile("" : "+v"(t));
    F.tid = t; F.lane = t & 63; F.wave = __builtin_amdgcn_readfirstlane(t >> 6);
    int bx = blockIdx.x, G = gridDim.x; asm volatile("" : "+s"(bx), "+s"(G));
    F.bx = bx; F.G = G; F.vcu = (G % 8 == 0) ? (bx % 8) * (G / 8) + bx / 8 : bx;
    const __attribute__((address_space(4))) Args* ap = (const __attribute__((address_space(4))) Args*)__builtin_amdgcn_kernarg_segment_ptr();
    asm volatile("" : "+s"(ap));
    F.ap = ap; F.ws = ap->ws; F.out = ap->out;
    return F;
}
#define FIN(F, k, ty) ((const ty*)(F).ap->in[k])
#define F_x(F) FIN(F, 0, float)
#define F_pos(F) FIN(F, 1, int)
#define F_g_mix(F) FIN(F, 2, float)
#define F_w_in(F) FIN(F, 3, float)
#define F_g_q_lat(F) FIN(F, 4, float)
#define F_w_uq(F) FIN(F, 5, float)
#define F_g_kv_lat(F) FIN(F, 6, float)
#define F_w_ukv(F) FIN(F, 7, float)
#define F_w_branch(F) FIN(F, 8, float)
#define F_w_out(F) FIN(F, 9, float)
#define F_g_ffn(F) FIN(F, 10, float)
#define F_w_gr(F) FIN(F, 11, float)
#define F_b_gr(F) FIN(F, 12, float)
#define F_w_er(F) FIN(F, 13, float)
#define F_b_er(F) FIN(F, 14, float)
#define F_w_gate(F) FIN(F, 15, float)
#define F_w_up(F) FIN(F, 16, float)
#define F_w_down(F) FIN(F, 17, float)
#define F_g_final(F) FIN(F, 18, float)
#define F_ctl(F) ((unsigned*)((F).ws + WS_CTL))
#define F_tok_e(F) ((int*)((F).ws + WS_RT + RT_E))
#define F_tok_w(F) ((float*)((F).ws + WS_RT + RT_W))
#define F_tok_rank(F) ((int*)((F).ws + WS_RT + RT_RANK))
#define F_tok_pos(F) ((int*)((F).ws + WS_RT + RT_POS))
#define F_blk_cnt(F) ((int*)((F).ws + WS_RT + RT_CNT))
#define F_statq(F) ((float*)((F).ws + WS_RT + RT_SQ))
#define F_statkv(F) ((float*)((F).ws + WS_RT + RT_SKV))
#define F_cs64(F) ((float*)((F).ws + WS_CS64))
#define F_cs32(F) ((float*)((F).ws + WS_CS32))
#define F_Win_t(F) ((bf16*)((F).ws + WS_WIN))
#define F_Wup_t(F) ((bf16*)((F).ws + WS_WUP))
#define F_Wb_t(F) ((bf16*)((F).ws + WS_WB))
#define F_Wout_t(F) ((bf16*)((F).ws + WS_WOUT))
#define F_W1_t(F) ((bf16*)((F).ws + WS_W1))
#define F_W2_t(F) ((bf16*)((F).ws + WS_W2))
#define F_H(F) ((bf16*)((F).ws + WS_H))
#define F_MQ(F) ((bf16*)((F).ws + WS_MQ))
#define F_OBR(F) ((bf16*)((F).ws + WS_OBR))
#define F_PROJ(F) ((bf16*)((F).ws + WS_PROJ))
#define F_HPERM(F) ((bf16*)((F).ws + WS_HPERM))
#define F_HID(F) ((bf16*)((F).ws + WS_HID))
#define F_YBUF(F) ((bf16*)((F).ws + WS_YBUF))
#define LDS_WAIT() asm volatile("s_waitcnt lgkmcnt(0)" ::: "memory")
template <int CTRL, int RMASK> DI float dpp_add(float v) { const int t = __builtin_amdgcn_update_dpp(0, __float_as_int(v), CTRL, RMASK, 0xf, true); return v + __int_as_float(t); }
DI float wave_sum(float v) {
    v = dpp_add<0xB1, 0xf>(v);
    v = dpp_add<0x4E, 0xf>(v);
    v = dpp_add<0x141, 0xf>(v);
    v = dpp_add<0x140, 0xf>(v);
    v = dpp_add<0x142, 0xa>(v);
    v = dpp_add<0x143, 0xc>(v);
    return __int_as_float(__builtin_amdgcn_readlane(__float_as_int(v), 63));
}

DI void pre_tables(Frame& F) {
    const int gt = F.bx * 512 + F.tid, NT_ = F.G * 512;
    for (int idx = gt; idx < T * 48; idx += NT_) {
        const int t = idx / 48, i = idx % 48;
        const float p = (float)F_pos(F)[t];
        float inv;
        if (i < 32) inv = powf(10000.0f, -(float)(2 * i) / 64.0f); else inv = powf(10000.0f, -(float)(2 * (i - 32)) / 32.0f);
        const float ang = p * inv;
        double rev = (double)ang * 0.15915494309189535; rev -= floor(rev);
        const float rf = (float)rev;
        const float sn = __builtin_amdgcn_sinf(rf), cn = __builtin_amdgcn_cosf(rf);
        if (i < 32) { F_cs64(F)[((size_t)t * 32 + i) * 2] = cn; F_cs64(F)[((size_t)t * 32 + i) * 2 + 1] = sn; }
        else { F_cs32(F)[((size_t)t * 16 + (i - 32)) * 2] = cn; F_cs32(F)[((size_t)t * 16 + (i - 32)) * 2 + 1] = sn; }
    }
}

struct ColSrc { const float* p; int stride; float scale; int klo, khi; const float* kg; };
template <class Map>
DI void conv_item(const Map& mp, int K, int N, bf16* WT, LAS float* scr, int item, int lane, const float* safe) {
    const int nblk = N / 32, kb = item / nblk, nb = item % nblk, k0 = 64 * kb, n0 = 32 * nb;
    const ColSrc cs = mp(n0 + (lane & 31));
    const bool valid = cs.p != nullptr && k0 >= cs.klo && k0 < cs.khi;
    const float* p = valid ? cs.p + (size_t)(k0 - cs.klo) * cs.stride : safe;
    const float* kg = (valid && cs.kg) ? cs.kg + (k0 - cs.klo) : safe;
    const int st = valid ? cs.stride : 0, kst = (valid && cs.kg) ? 1 : 0; const bool hasg = valid && cs.kg != nullptr;
    const float sc = cs.scale;
#pragma unroll 8
    for (int i = 0; i < 32; ++i) {
        const int kk = 2 * i + (lane >> 5);
        float v = p[(size_t)kk * st] * sc;
        if (Map::HAS_KG) { const float gq = kg[kk * kst]; v = hasg ? v * gq : v; }
        v = valid ? v : 0.f;
        scr[kk * 33 + (lane & 31)] = v;
    }
    LDS_WAIT();
    const int c = lane & 7;
#pragma unroll
    for (int j = 0; j < 4; ++j) { const int n = (lane >> 3) + 8 * j; const LAS float* s = scr + (8 * c) * 33 + n;
        u32x4 o; o.x = pk2(s[0 * 33], s[1 * 33]); o.y = pk2(s[2 * 33], s[3 * 33]); o.z = pk2(s[4 * 33], s[5 * 33]); o.w = pk2(s[6 * 33], s[7 * 33]);
        *(u32x4*)(WT + (size_t)(n0 + n) * K + k0 + 8 * c) = o; }
    LDS_WAIT();
}
struct MapWin { const float* w; static constexpr bool HAS_KG = false;
    DI ColSrc operator()(int n) const {
        ColSrc c{nullptr, INC, 1.f, 0, 1024, nullptr};
        if (n < 768) { c.p = w + n; if (n < 256) c.scale = C_SB; }
        else if (n < 1280) { const int j = n - 768; if (j < 384) c.p = w + 768 + j; else if (j < 416) { const int p = j - 384; c.p = w + 1152 + (p >> 1) + 16 * (p & 1); } }
        else if (n < 3584) { const int j = n - 1280, gi = j / 768, rem = j % 768, which = rem >> 8, hd = (rem >> 6) & 3, dd = rem & 63;
            const int sd = which < 2 ? (dd >> 1) + 32 * (dd & 1) : dd; c.p = w + 1184 + gi * 768 + which * 256 + hd * 64 + sd; if (which == 0) c.scale = C_SB; }
        else c.p = w + 3488 + (n - 3584);
        return c; } };
struct MapWup { const float* wuq; const float* wukv; const float* gq; const float* gkv; static constexpr bool HAS_KG = true;
    DI ColSrc operator()(int n) const {
        ColSrc c{nullptr, 1, 1.f, 0, 0, nullptr};
        if (n < 384) { const int hd = n / 96, wi = n % 96; const int col = wi < 64 ? hd * 96 + wi : hd * 96 + 64 + ((wi - 64) >> 1) + 16 * ((wi - 64) & 1);
            c.p = wuq + col; c.stride = 384; c.klo = 0; c.khi = 256; c.kg = gq; }
        else if (n < 896) { c.p = wukv + (n - 384); c.stride = 512; c.klo = 256; c.khi = 384; c.kg = gkv; }
        return c; } };
struct MapWb { const float* w; static constexpr bool HAS_KG = false;
    DI ColSrc operator()(int n) const { ColSrc c{w + (size_t)(n >> 10) * 256 * 1024 + (n & 1023), 1024, 1.f, 0, 256, nullptr}; return c; } };
struct MapWout { const float* w; static constexpr bool HAS_KG = false;
    DI ColSrc operator()(int n) const { ColSrc c{w + n, 1024, 1.f, 0, 1024, nullptr}; return c; } };
struct MapW1 { const float* wg; const float* wu; static constexpr bool HAS_KG = false;
    DI ColSrc operator()(int n) const { const int e = n >> 9, rem = n & 511, j = rem >> 8, rr = rem & 255;
        ColSrc c{nullptr, 256, 1.f, 0, 1024, nullptr};
        c.p = (rr < 128) ? wg + (size_t)e * 1024 * 256 + 128 * j + rr : wu + (size_t)e * 1024 * 256 + 128 * j + (rr - 128); return c; } };
struct MapW2 { const float* w; static constexpr bool HAS_KG = false;
    DI ColSrc operator()(int n) const { ColSrc c{w + (size_t)(n >> 10) * 256 * 1024 + (n & 1023), 1024, 1.f, 0, 256, nullptr}; return c; } };

DI void conv_phase(Frame& F, int l) {
    LAS float* scr = (LAS float*)(F.lds + F.wave * 16384);
    const int gw = F.vcu * 8 + F.wave, NGW = F.G * 8;
    constexpr int I_IN = 16 * (NPROJ / 32), I_UP = 8 * 32, I_B = 4 * 96, I_O = 16 * 32, I_1 = 16 * 256, I_2 = 4 * 512;
    constexpr int NITEMS = I_IN + I_UP + I_B + I_O + I_1 + I_2;
    const MapWin m_in{F_w_in(F) + (size_t)l * 1024 * INC};
    const MapWup m_up{F_w_uq(F) + (size_t)l * 256 * 384, F_w_ukv(F) + (size_t)l * 128 * 512, F_g_q_lat(F) + l * 256, F_g_kv_lat(F) + l * 128};
    const MapWb m_b{F_w_branch(F) + (size_t)l * 3 * 256 * 1024};
    const MapWout m_o{F_w_out(F) + (size_t)l * 1024 * 1024};
    const MapW1 m_1{F_w_gate(F) + (size_t)l * 16 * 1024 * 256, F_w_up(F) + (size_t)l * 16 * 1024 * 256};
    const MapW2 m_2{F_w_down(F) + (size_t)l * 16 * 256 * 1024};
    const float* safe = F_g_final(F);
    for (int it = gw; it < NITEMS; it += NGW) {
        int r = it;
        if (r < I_IN) { conv_item(m_in, 1024, NPROJ, F_Win_t(F), scr, r, F.lane, safe); continue; } r -= I_IN;
        if (r < I_UP) { conv_item(m_up, 512, 1024, F_Wup_t(F), scr, r, F.lane, safe); continue; } r -= I_UP;
        if (r < I_B) { conv_item(m_b, 256, 3072, F_Wb_t(F), scr, r, F.lane, safe); continue; } r -= I_B;
        if (r < I_O) { conv_item(m_o, 1024, 1024, F_Wout_t(F), scr, r, F.lane, safe); continue; } r -= I_O;
        if (r < I_1) { conv_item(m_1, 1024, 8192, F_W1_t(F), scr, r, F.lane, safe); continue; } r -= I_1;
        conv_item(m_2, 256, 16384, F_W2_t(F), scr, r, F.lane, safe);
    }
}

template <bool FINAL>
DI void norm_phase(Frame& F, int l, const float* gain) {
    const int gw = F.vcu * 8 + F.wave, NGW = F.G * 8;
    const float* src = (l == 0) ? F_x(F) : F.out;
    const int lo4 = 4 * F.lane;
    constexpr int R = 4;
    for (int m0 = gw; m0 < T; m0 += NGW * R) {
        f32x4 v[R][4];
#pragma unroll
        for (int r = 0; r < R; ++r)
#pragma unroll
            for (int j = 0; j < 4; ++j) v[r][j] = *(const f32x4*)(src + (size_t)(m0 + r * NGW) * D + lo4 + 256 * j);
        if (l > 0) {
            int p0[R], p1[R]; float w0[R], w1[R];
#pragma unroll
            for (int r = 0; r < R; ++r) { const int m = m0 + r * NGW; p0[r] = F_tok_pos(F)[2 * m]; p1[r] = F_tok_pos(F)[2 * m + 1]; w0[r] = F_tok_w(F)[2 * m]; w1[r] = F_tok_w(F)[2 * m + 1]; }
#pragma unroll
            for (int r = 0; r < R; ++r)
#pragma unroll
                for (int j = 0; j < 4; ++j) {
                    const u32x2 y0 = *(const u32x2*)(F_YBUF(F) + (size_t)p0[r] * D + lo4 + 256 * j), y1 = *(const u32x2*)(F_YBUF(F) + (size_t)p1[r] * D + lo4 + 256 * j);
                    v[r][j].x += w0[r] * bflo(y0.x) + w1[r] * bflo(y1.x); v[r][j].y += w0[r] * bfhi(y0.x) + w1[r] * bfhi(y1.x);
                    v[r][j].z += w0[r] * bflo(y0.y) + w1[r] * bflo(y1.y); v[r][j].w += w0[r] * bfhi(y0.y) + w1[r] * bfhi(y1.y);
                }
        }
#pragma unroll
        for (int r = 0; r < R; ++r) {
            const int m = m0 + r * NGW;
            float ss = 0.f;
#pragma unroll
            for (int j = 0; j < 4; ++j) ss += (v[r][j].x * v[r][j].x + v[r][j].y * v[r][j].y) + (v[r][j].z * v[r][j].z + v[r][j].w * v[r][j].w);
            ss = wave_sum(ss);
            const float rstd = 1.0f / sqrtf(ss * (1.0f / D) + EPS);
#pragma unroll
            for (int j = 0; j < 4; ++j) {
                const f32x4 g = *(const f32x4*)(gain + lo4 + 256 * j);
                if (FINAL) { *(f32x4*)(F.out + (size_t)m * D + lo4 + 256 * j) = v[r][j] * rstd * g; }
                else {
                    *(f32x4*)(F.out + (size_t)m * D + lo4 + 256 * j) = v[r][j];
                    const f32x4 hh = v[r][j] * rstd * g; u32x2 o; o.x = pk2(hh.x, hh.y); o.y = pk2(hh.z, hh.w);
                    *(u32x2*)(F_H(F) + (size_t)m * D + lo4 + 256 * j) = o;
                }
            }
        }
    }
}

typedef f32x4 AccT[2][2][4][2];
DI void rope4(f32x4& v, const f32x4 t) { const float a = v.x * t.x - v.y * t.y, b = v.x * t.y + v.y * t.x, c = v.z * t.z - v.w * t.w, d = v.z * t.w + v.w * t.z; v = (f32x4){a, b, c, d}; }
DI void store8(bf16* p, const f32x4 v0, const f32x4 v1) { u32x4 w; w.x = pk2(v0.x, v0.y); w.y = pk2(v0.z, v0.w); w.z = pk2(v1.x, v1.y); w.w = pk2(v1.z, v1.w); *(u32x4*)p = w; }

struct EpiInproj {
    static constexpr bool PERM = true;
    bf16* O; const f32x4* cs64; const f32x4* cs32; float* statq; float* statkv;
    DI bool keep(const Unit&) const { return false; }
    DI void operator()(AccT& acc, const Unit& u, int wr, int wc, int fr, int fq) const {
        const int row0 = u.pm * 256 + wr * 64 + fr;
        if (u.pn == 3 || u.pn == 4) {
            float* st = (u.pn == 3) ? statq : statkv;
#pragma unroll
            for (int ai = 0; ai < 2; ++ai)
#pragma unroll
                for (int m = 0; m < 4; ++m) {
                    float ss = 0.f;
#pragma unroll
                    for (int n = 0; n < 2; ++n) { const f32x4 a = acc[ai][0][m][n], b = acc[ai][1][m][n];
                        ss += (a.x * a.x + a.y * a.y) + (a.z * a.z + a.w * a.w); if (u.pn == 3) ss += (b.x * b.x + b.y * b.y) + (b.z * b.z + b.w * b.w); }
                    ss += __shfl_xor(ss, 16); ss += __shfl_xor(ss, 32);
                    if (fq == 0) st[(size_t)(row0 + ai * 128 + m * 16) * 4 + wc] = ss;
                }
        }
#pragma unroll
        for (int bj = 0; bj < 2; ++bj) {
            const int cg = u.pn * 256 + bj * 128 + wc * 32;
            int mode = 0;
            if (cg >= PJ_GATE) mode = 3;
            else if (cg >= PJ_DIL) { const int which = ((cg - PJ_DIL) % 768) >> 8; mode = which < 2 ? 1 : 0; }
            else if (cg == PJ_KR) mode = 2;
            const int col0 = cg + 8 * fq;
#pragma unroll
            for (int ai = 0; ai < 2; ++ai)
#pragma unroll
                for (int m = 0; m < 4; ++m) {
                    const int row = row0 + ai * 128 + m * 16;
                    f32x4 v0 = acc[ai][bj][m][0], v1 = acc[ai][bj][m][1];
                    if (mode == 1) { const f32x4* t = cs64 + (size_t)row * 16 + 8 * ((cg >> 5) & 1) + 2 * fq; rope4(v0, t[0]); rope4(v1, t[1]); }
                    else if (mode == 2) { const f32x4* t = cs32 + (size_t)row * 8 + 2 * fq; rope4(v0, t[0]); rope4(v1, t[1]); }
                    else if (mode == 3) {
#pragma unroll
                        for (int e = 0; e < 4; ++e) { v0[e] = fminf(1.0f + fexp2(-LOG2E * v0[e]), 1e30f); v1[e] = fminf(1.0f + fexp2(-LOG2E * v1[e]), 1e30f); }
                    }
                    store8(O + (size_t)row * NPROJ + col0, v0, v1);
                }
        }
    }
};

struct EpiMlaUp {
    static constexpr bool PERM = true;
    bf16* O; const f32x4* sq; const f32x4* skv; const f32x4* cs32;
    DI bool keep(const Unit&) const { return false; }
    DI void operator()(AccT& acc, const Unit& u, int wr, int wc, int fr, int fq) const {
        const int row0 = u.pm * 256 + wr * 64 + fr;
#pragma unroll
        for (int bj = 0; bj < 2; ++bj) {
            const int gidx = (u.pn * 256 + bj * 128 + wc * 32) >> 5; const bool isq = gidx < 12, rope = isq && (gidx % 3 == 2);
            const int col0 = gidx * 32 + 8 * fq;
            const f32x4* sp = isq ? sq : skv; const float mul = isq ? C_MLA : 1.0f, inv = isq ? (1.0f / 256.0f) : (1.0f / 128.0f);
#pragma unroll
            for (int ai = 0; ai < 2; ++ai) {
                f32x4 ps[4], t0[4], t1[4];
#pragma unroll
                for (int m = 0; m < 4; ++m) ps[m] = sp[row0 + ai * 128 + m * 16];
                if (rope) {
#pragma unroll
                    for (int m = 0; m < 4; ++m) { const f32x4* t = cs32 + (size_t)(row0 + ai * 128 + m * 16) * 8 + 2 * fq; t0[m] = t[0]; t1[m] = t[1]; }
                }
#pragma unroll
                for (int m = 0; m < 4; ++m) {
                    const int row = row0 + ai * 128 + m * 16;
                    const float sc = mul / sqrtf(((ps[m].x + ps[m].y) + (ps[m].z + ps[m].w)) * inv + EPS);
                    f32x4 v0 = acc[ai][bj][m][0] * sc, v1 = acc[ai][bj][m][1] * sc;
                    if (rope) { rope4(v0, t0[m]); rope4(v1, t1[m]); }
                    store8(O + (size_t)row * D + col0, v0, v1);
                }
            }
        }
    }
};

struct EpiMerge {
    static constexpr bool PERM = true;
    bf16* O; const bf16* P;
    DI bool keep(const Unit& u) const { return (u.pn >> 2) < 2; }
    DI static void rcp8(const u32x4 d, f32x4& f0, f32x4& f1) {
        f0.x = frcp(bflo(d.x)); f0.y = frcp(bfhi(d.x)); f0.z = frcp(bflo(d.y)); f0.w = frcp(bfhi(d.y));
        f1.x = frcp(bflo(d.z)); f1.y = frcp(bfhi(d.z)); f1.z = frcp(bflo(d.w)); f1.w = frcp(bfhi(d.w)); }
    DI void operator()(AccT& acc, const Unit& u, int wr, int wc, int fr, int fq) const {
        const int row0 = u.pm * 256 + wr * 64 + fr, n = u.pn >> 2, jt = u.pn & 3;
        const bf16* gp0 = P + (size_t)row0 * NPROJ + PJ_GATE + n * 1024 + jt * 256 + wc * 32 + 8 * fq;
        if (n < 2) {
#pragma unroll
            for (int bj = 0; bj < 2; ++bj) {
                u32x4 da[2][4], db[2][4];
#pragma unroll
                for (int ai = 0; ai < 2; ++ai)
#pragma unroll
                    for (int m = 0; m < 4; ++m) { const bf16* gp = gp0 + (size_t)(ai * 128 + m * 16) * NPROJ + bj * 128; da[ai][m] = *(const u32x4*)gp; db[ai][m] = *(const u32x4*)(gp + 1024); }
#pragma unroll
                for (int ai = 0; ai < 2; ++ai)
#pragma unroll
                    for (int m = 0; m < 4; ++m) {
                        f32x4 f0, f1; rcp8(da[ai][m], f0, f1); const u32x4 b = db[ai][m];
                        f0.x *= bflo(b.x); f0.y *= bfhi(b.x); f0.z *= bflo(b.y); f0.w *= bfhi(b.y);
                        f1.x *= bflo(b.z); f1.y *= bfhi(b.z); f1.z *= bflo(b.w); f1.w *= bfhi(b.w);
                        acc[ai][bj][m][0] *= f0; acc[ai][bj][m][1] *= f1;
                    }
            }
        } else {
#pragma unroll
            for (int bj = 0; bj < 2; ++bj) {
                u32x4 da[2][4];
#pragma unroll
                for (int ai = 0; ai < 2; ++ai)
#pragma unroll
                    for (int m = 0; m < 4; ++m) da[ai][m] = *(const u32x4*)(gp0 + (size_t)(ai * 128 + m * 16) * NPROJ + bj * 128);
#pragma unroll
                for (int ai = 0; ai < 2; ++ai)
#pragma unroll
                    for (int m = 0; m < 4; ++m) {
                        f32x4 f0, f1; rcp8(da[ai][m], f0, f1);
                        store8(O + (size_t)(row0 + ai * 128 + m * 16) * D + jt * 256 + bj * 128 + wc * 32 + 8 * fq, acc[ai][bj][m][0] * f0, acc[ai][bj][m][1] * f1);
                    }
            }
        }
    }
};
struct MergeOrder { int G, c;
    DI bool next(int i, Unit& u) const { const int tile = c + (i / 3) * G; if (tile >= 256) return false; const int n = i % 3; u.pm = tile >> 2; u.pn = n * 4 + (tile & 3); u.ka = n * 256; return true; } };

struct EpiResid {
    static constexpr bool PERM = false;
    float* X;
    DI bool keep(const Unit&) const { return false; }
    DI void operator()(AccT& acc, const Unit& u, int wr, int wc, int fr, int fq) const {
        float* rp0 = X + (size_t)(u.pm * 256 + wr * 64 + fr) * D + u.pn * 256 + wc * 32 + 4 * fq;
#pragma unroll
        for (int bj = 0; bj < 2; ++bj)
#pragma unroll
            for (int n = 0; n < 2; ++n) {
                f32x4 old[2][4];
#pragma unroll
                for (int ai = 0; ai < 2; ++ai)
#pragma unroll
                    for (int m = 0; m < 4; ++m) old[ai][m] = *(const f32x4*)(rp0 + (size_t)(ai * 128 + m * 16) * D + bj * 128 + n * 16);
#pragma unroll
                for (int ai = 0; ai < 2; ++ai)
#pragma unroll
                    for (int m = 0; m < 4; ++m) *(f32x4*)(rp0 + (size_t)(ai * 128 + m * 16) * D + bj * 128 + n * 16) = old[ai][m] + acc[ai][bj][m][n];
            }
    }
};

struct EpiSwiglu {
    static constexpr bool PERM = true;
    bf16* O;
    DI bool keep(const Unit&) const { return false; }
    DI void operator()(AccT& acc, const Unit& u, int wr, int wc, int fr, int fq) const {
        const int row0 = u.pm * 256 + wr * 64 + fr, col0 = (u.pn & 1) * 128 + wc * 32 + 8 * fq;
#pragma unroll
        for (int ai = 0; ai < 2; ++ai)
#pragma unroll
            for (int m = 0; m < 4; ++m) {
                f32x4 r[2];
#pragma unroll
                for (int n = 0; n < 2; ++n) { const f32x4 gt = acc[ai][0][m][n], up = acc[ai][1][m][n];
#pragma unroll
                    for (int e = 0; e < 4; ++e) r[n][e] = gt[e] * up[e] * frcp(1.0f + fexp2(-LOG2E * gt[e])); }
                store8(O + (size_t)(row0 + ai * 128 + m * 16) * 256 + col0, r[0], r[1]);
            }
    }
};
struct EpiY {
    static constexpr bool PERM = true;
    bf16* O;
    DI bool keep(const Unit&) const { return false; }
    DI void operator()(AccT& acc, const Unit& u, int wr, int wc, int fr, int fq) const {
        const int row0 = u.pm * 256 + wr * 64 + fr;
#pragma unroll
        for (int bj = 0; bj < 2; ++bj) { const int col0 = (u.pn & 3) * 256 + bj * 128 + wc * 32 + 8 * fq;
#pragma unroll
            for (int ai = 0; ai < 2; ++ai)
#pragma unroll
                for (int m = 0; m < 4; ++m) store8(O + (size_t)(row0 + ai * 128 + m * 16) * D + col0, acc[ai][bj][m][0], acc[ai][bj][m][1]); }
    }
};
struct MoeOrder { const LAS int* ts; int nN, G, c;
    DI bool next(int i, Unit& u) const {
        const int L = i * G + c; const int ntile = __builtin_amdgcn_readfirstlane(ts[16]); if (L >= ntile * nN) return false;
        const int pm = L / nN, j = L - pm * nN; int e = 0;
#pragma unroll
        for (int k = 1; k < 16; ++k) e += (pm >= ts[k]) ? 1 : 0;
        e = __builtin_amdgcn_readfirstlane(e);
        u.pm = pm; u.pn = e * nN + j; u.ka = 0; return true; } };

DI void route_phase(Frame& F, int l) {
    LAS float* Wr = (LAS float*)F.lds;
    LAS int* eid = (LAS int*)(F.lds + 98304);
    const float* wg = F_w_gr(F) + (size_t)l * 1024 * 4; const float* we = F_w_er(F) + (size_t)l * 1024 * 16;
    for (int i = F.tid; i < 4096; i += 512) Wr[(i & 3) * 1024 + (i >> 2)] = wg[i];
    for (int i = F.tid; i < 16384; i += 512) Wr[(4 + (i & 15)) * 1024 + (i >> 4)] = we[i];
    __syncthreads();
    const int tok0 = F.bx * 64 + F.wave * 8;
    f32x4 xv[8][4], g[4];
#pragma unroll
    for (int j = 0; j < 4; ++j) g[j] = *(const f32x4*)(F_g_ffn(F) + l * 1024 + 4 * F.lane + 256 * j);
#pragma unroll
    for (int i = 0; i < 8; ++i)
#pragma unroll
        for (int j = 0; j < 4; ++j) xv[i][j] = *(const f32x4*)(F.out + (size_t)(tok0 + i) * D + 4 * F.lane + 256 * j);
#pragma unroll
    for (int i = 0; i < 8; ++i) {
        float ss = 0.f;
#pragma unroll
        for (int j = 0; j < 4; ++j) ss += (xv[i][j].x * xv[i][j].x + xv[i][j].y * xv[i][j].y) + (xv[i][j].z * xv[i][j].z + xv[i][j].w * xv[i][j].w);
        ss = wave_sum(ss);
        const float rstd = 1.0f / sqrtf(ss * (1.0f / D) + EPS);
#pragma unroll
        for (int j = 0; j < 4; ++j) { xv[i][j] = xv[i][j] * rstd * g[j]; u32x2 o; o.x = pk2(xv[i][j].x, xv[i][j].y); o.y = pk2(xv[i][j].z, xv[i][j].w);
            *(u32x2*)(F_H(F) + (size_t)(tok0 + i) * D + 4 * F.lane + 256 * j) = o; }
    }
    LAS float* lgs = (LAS float*)(F.lds + 100352) + F.wave * 160;
#pragma unroll 1
    for (int c = 0; c < 20; ++c) {
        f32x4 w[4];
#pragma unroll
        for (int j = 0; j < 4; ++j) w[j] = *(const LAS f32x4*)(Wr + c * 1024 + 4 * F.lane + 256 * j);
#pragma unroll
        for (int i = 0; i < 8; ++i) {
            float p = 0.f;
#pragma unroll
            for (int j = 0; j < 4; ++j) p += (xv[i][j].x * w[j].x + xv[i][j].y * w[j].y) + (xv[i][j].z * w[j].z + xv[i][j].w * w[j].w);
            p = wave_sum(p);
            if (F.lane == 0) lgs[i * 20 + c] = p;
        }
    }
    LDS_WAIT();
    float lg[20];
#pragma unroll
    for (int c = 0; c < 20; ++c) lg[c] = lgs[(F.lane & 7) * 20 + c];
    {
        float gl[4], el[16];
#pragma unroll
        for (int c = 0; c < 4; ++c) gl[c] = lg[c] + F_b_gr(F)[l * 4 + c];
#pragma unroll
        for (int c = 0; c < 16; ++c) el[c] = lg[4 + c] + F_b_er(F)[l * 16 + c];
        int gsel = 0; float best = gl[0];
#pragma unroll
        for (int c = 1; c < 4; ++c) if (gl[c] > best) { best = gl[c]; gsel = c; }
        float den = 0.f;
#pragma unroll
        for (int c = 0; c < 4; ++c) den += expf(gl[c] - best);
        const float pg = 1.0f / den;
        float ig[4];
#pragma unroll
        for (int e = 0; e < 4; ++e) ig[e] = gsel == 0 ? el[e] : gsel == 1 ? el[4 + e] : gsel == 2 ? el[8 + e] : el[12 + e];
        int ia = 0; float va = ig[0];
#pragma unroll
        for (int e = 1; e < 4; ++e) if (ig[e] > va) { va = ig[e]; ia = e; }
        int ib = -1; float vb = -INFINITY;
#pragma unroll
        for (int e = 0; e < 4; ++e) if (e != ia && ig[e] > vb) { vb = ig[e]; ib = e; }
        if (ib < 0) ib = (ia + 1) & 3;
        const float pa = 1.0f / (1.0f + expf(vb - va)), pb = 1.0f - pa;
        if (F.lane < 8) {
            const int t = tok0 + F.lane, e0 = 4 * gsel + ia, e1 = 4 * gsel + ib;
            F_tok_e(F)[2 * t] = e0; F_tok_e(F)[2 * t + 1] = e1; F_tok_w(F)[2 * t] = pg * pa; F_tok_w(F)[2 * t + 1] = pg * pb;
            eid[(F.wave * 8 + F.lane) * 2] = e0; eid[(F.wave * 8 + F.lane) * 2 + 1] = e1;
        }
    }
    __syncthreads();
    if (F.wave == 0) {
        const int e0 = eid[2 * F.lane], e1 = eid[2 * F.lane + 1];
        const unsigned long long lt = (1ull << F.lane) - 1ull;
        int r0 = 0, r1 = 0, cnt = 0;
#pragma unroll
        for (int ee = 0; ee < 16; ++ee) {
            const unsigned long long m0 = __ballot(e0 == ee), m1 = __ballot(e1 == ee);
            const int c0 = __popcll(m0);
            if (e0 == ee) r0 = __popcll(m0 & lt);
            if (e1 == ee) r1 = c0 + __popcll(m1 & lt);
            if (F.lane == ee) cnt = c0 + __popcll(m1);
        }
        const int t = F.bx * 64 + F.lane;
        F_tok_rank(F)[2 * t] = r0; F_tok_rank(F)[2 * t + 1] = r1;
        if (F.lane < 16) F_blk_cnt(F)[F.bx * 16 + F.lane] = cnt;
    }
}

DI void moe_tables(Frame& F) {
    LAS int* ctl = (LAS int*)(F.lds + LDSCTL_OFF);
    if (F.tid < 32) ctl[LC_TOT / 4 + F.tid] = 0;
    __syncthreads();
    {
        const int e = F.tid & 15; int tot = 0, base = 0;
#pragma unroll
        for (int j = 0; j < 8; ++j) { const int b = (F.tid >> 4) + 32 * j; const int c = (b < F.G) ? F_blk_cnt(F)[b * 16 + e] : 0; tot += c; base += (b < F.bx) ? c : 0; }
        tot += __shfl_xor(tot, 16); tot += __shfl_xor(tot, 32); base += __shfl_xor(base, 16); base += __shfl_xor(base, 32);
        if (F.lane < 16) { __hip_atomic_fetch_add(ctl + LC_TOT / 4 + e, tot, __ATOMIC_RELAXED, __HIP_MEMORY_SCOPE_WORKGROUP); __hip_atomic_fetch_add(ctl + LC_BASE / 4 + e, base, __ATOMIC_RELAXED, __HIP_MEMORY_SCOPE_WORKGROUP); }
    }
    __syncthreads();
    if (F.tid == 0) { int acc = 0; for (int e = 0; e < 16; ++e) { ctl[LC_SEG / 4 + e] = acc * 256; ctl[LC_TS / 4 + e] = acc; acc += (ctl[LC_TOT / 4 + e] + 255) >> 8; } ctl[LC_TS / 4 + 16] = acc; }
    __syncthreads();
}

DI void perm_phase(Frame& F) {
    moe_tables(F);
    const LAS int* ctl = (const LAS int*)(F.lds + LDSCTL_OFF);
    const int tw = F.bx * 64 + F.wave * 8;
    int pos = 0;
    if (F.lane < 16) { const int idx = 2 * tw + F.lane; const int e = F_tok_e(F)[idx], r = F_tok_rank(F)[idx]; pos = ctl[LC_SEG / 4 + e] + ctl[LC_BASE / 4 + e] + r; F_tok_pos(F)[idx] = pos; }
    u32x4 va[8], vb[8];
#pragma unroll
    for (int i = 0; i < 8; ++i) { const u32x4* s = (const u32x4*)(F_H(F) + (size_t)(tw + i) * D); va[i] = s[F.lane]; vb[i] = s[F.lane + 64]; }
#pragma unroll
    for (int i = 0; i < 8; ++i)
#pragma unroll
        for (int k = 0; k < 2; ++k) { const int p = __builtin_amdgcn_readlane(pos, 2 * i + k); u32x4* d = (u32x4*)(F_HPERM(F) + (size_t)p * D); d[F.lane] = va[i]; d[F.lane + 64] = vb[i]; }
}

#define MFMA32(a, b, c) __builtin_amdgcn_mfma_f32_32x32x16_bf16((a), (b), (c), 0, 0, 0)
DI int crow(int i, int h) { return (i & 3) + 8 * (i >> 2) + 4 * h; }
DI bf16x8 pack8(const f32x16& x, int s) { u32x4 p; p.x = pk2(x[8 * s], x[8 * s + 1]); p.y = pk2(x[8 * s + 2], x[8 * s + 3]); p.z = pk2(x[8 * s + 4], x[8 * s + 5]); p.w = pk2(x[8 * s + 6], x[8 * s + 7]); return __builtin_bit_cast(bf16x8, p); }
DI s16x4 tr_read(const LAS unsigned char* p) { return __builtin_bit_cast(s16x4, __builtin_amdgcn_ds_read_tr16_b64_v4i16((LAS v4i16_t*)p)); }
constexpr int VP = 144;
DI bf16x8 vfrag(const LAS unsigned char* vlane, int off) { const s16x4 lo = tr_read(vlane + off), hi = tr_read(vlane + off + 8 * VP); return __builtin_shufflevector(lo, hi, 0, 1, 2, 3, 4, 5, 6, 7); }
DI void pv_accum(f32x16 (&oT)[2], const LAS unsigned char* vlane, const bf16x8 (&pp)[2][2]) {
#pragma unroll
    for (int blk = 0; blk < 2; ++blk)
#pragma unroll
        for (int s = 0; s < 2; ++s)
#pragma unroll
            for (int db = 0; db < 2; ++db) oT[db] = MFMA32(vfrag(vlane, (32 * blk + 16 * s) * VP + db * 64), pp[blk][s], oT[db]);
}
DI void softmax_tile(const f32x16& s0, const f32x16& s1, float& mrun, float& lrun, f32x16 (&oT)[2], bf16x8 (&pp)[2][2]) {
    float mx = fmaxf(s0[0], s1[0]);
#pragma unroll
    for (int i = 1; i < 16; ++i) mx = fmaxf(mx, fmaxf(s0[i], s1[i]));
    mx = fmaxf(mx, __shfl_xor(mx, 32));
    const float mnew = fmaxf(mrun, mx), alpha = fexp2(mrun - mnew);
    mrun = mnew;
    f32x16 p0, p1; float rs = 0.f;
#pragma unroll
    for (int i = 0; i < 16; ++i) { p0[i] = fexp2(s0[i] - mnew); p1[i] = fexp2(s1[i] - mnew); rs += p0[i] + p1[i]; }
    lrun = lrun * alpha + rs;
#pragma unroll
    for (int i = 0; i < 16; ++i) { oT[0][i] *= alpha; oT[1][i] *= alpha; }
    pp[0][0] = pack8(p0, 0); pp[0][1] = pack8(p0, 1); pp[1][0] = pack8(p1, 0); pp[1][1] = pack8(p1, 1);
}
DI void store_oT(bf16* orow, const f32x16 (&oT)[2], float sc, int h) {
#pragma unroll
    for (int db = 0; db < 2; ++db)
#pragma unroll
        for (int gq = 0; gq < 4; ++gq) { u32x2 w; w.x = pk2(oT[db][4 * gq] * sc, oT[db][4 * gq + 1] * sc); w.y = pk2(oT[db][4 * gq + 2] * sc, oT[db][4 * gq + 3] * sc);
            *(u32x2*)(orow + 32 * db + 8 * gq + 4 * h) = w; }
}

constexpr int SB_KP = 144, SB_TILE = 64 * SB_KP, SB_BUF = 2 * SB_TILE;
constexpr float SB_DONE = 48.0f;
DI void sb_unit(Frame& F, int b, int hd, int qb) {
    const int lane = F.lane, r32 = lane & 31, h = lane >> 5, wave = F.wave;
    const int q0w = qb * 256 + wave * 32, qpos = q0w + r32;
    const size_t rowbase = (size_t)b * SEQ;
    const bf16* P = F_PROJ(F);
    bf16x8 qf[4];
#pragma unroll
    for (int s = 0; s < 4; ++s) qf[s] = *(const bf16x8*)(P + (rowbase + qpos) * NPROJ + PJ_SB + hd * 64 + 16 * s + 8 * h);
    bf16x8 tri[2], ones;
#pragma unroll
    for (int s = 0; s < 2; ++s)
#pragma unroll
        for (int j = 0; j < 8; ++j) tri[s][j] = ((16 * s + 8 * (j >> 2) + 4 * h + (j & 3)) > r32) ? (short)0x3F80 : (short)0;
#pragma unroll
    for (int j = 0; j < 8; ++j) ones[j] = (short)0x3F80;
    f32x16 oT[2], carry;
#pragma unroll
    for (int i = 0; i < 16; ++i) { oT[0][i] = 0.f; oT[1][i] = 0.f; carry[i] = 0.f; }
    const int NT = 4 * (qb + 1);
    const int srow = F.tid >> 3, sch = F.tid & 7;
    const bf16* kg = P + (rowbase + srow) * NPROJ + PJ_SB + 256 + hd * 64 + sch * 8;
    u32x4 kreg = *(const u32x4*)(kg + (size_t)(NT - 1) * 64 * NPROJ), vreg = *(const u32x4*)(kg + (size_t)(NT - 1) * 64 * NPROJ + 256);
    const int ldst = srow * SB_KP + sch * 16;
    const int klane = r32 * SB_KP + 16 * h;
    const int vlane_off = (4 * h + ((lane & 15) >> 2)) * VP + ((lane >> 4) & 1) * 32 + (lane & 3) * 8;
    volatile LAS int* flags = (volatile LAS int*)(F.lds + 2 * SB_BUF);
    bool wdone = false;
    for (int it = 0; it < NT; ++it) {
        const int kt = NT - 1 - it;
        LAS unsigned char* Kb = F.lds + (it & 1) * SB_BUF; LAS unsigned char* Vb = Kb + SB_TILE;
        *(LAS u32x4*)(Kb + ldst) = kreg; *(LAS u32x4*)(Vb + ldst) = vreg;
        if (lane == 0) flags[(it & 1) * 8 + wave] = wdone ? 1 : 0;
        __syncthreads();
        {
            const volatile LAS int* fl = flags + (it & 1) * 8;
            const int alld = fl[0] & fl[1] & fl[2] & fl[3] & fl[4] & fl[5] & fl[6] & fl[7];
            if (__builtin_amdgcn_readfirstlane(alld)) break;
        }
        if (it + 1 < NT) { kreg = *(const u32x4*)(kg + (size_t)(kt - 1) * 64 * NPROJ); vreg = *(const u32x4*)(kg + (size_t)(kt - 1) * 64 * NPROJ + 256); }
        if (kt * 64 < q0w + 31) {
            f32x16 st0, st1;
#pragma unroll
            for (int i = 0; i < 16; ++i) { st0[i] = 0.f; st1[i] = 0.f; }
#pragma unroll
            for (int s = 0; s < 4; ++s) {
                const bf16x8 k0 = *(const LAS bf16x8*)(Kb + klane + 32 * s), k1 = *(const LAS bf16x8*)(Kb + klane + 32 * SB_KP + 32 * s);
                st0 = MFMA32(k0, qf[s], st0); st1 = MFMA32(k1, qf[s], st1);
            }
            f32x16 sp0, sp1;
            const int kb0 = kt * 64 + 4 * h;
#pragma unroll
            for (int i = 0; i < 16; ++i) {
                const int key0 = kb0 + (i & 3) + 8 * (i >> 2);
                st0[i] = fminf(st0[i], 126.f); st1[i] = fminf(st1[i], 126.f);
                const float a0 = flog2(1.0f + fexp2(st0[i])), a1 = flog2(1.0f + fexp2(st1[i]));
                sp0[i] = (key0 < qpos) ? a0 : 0.f; sp1[i] = (key0 + 32 < qpos) ? a1 : 0.f;
            }
            const bf16x8 s00 = pack8(sp0, 0), s01 = pack8(sp0, 1), s10 = pack8(sp1, 0), s11 = pack8(sp1, 1);
            f32x16 t1 = MFMA32(ones, s10, carry); t1 = MFMA32(ones, s11, t1);
            f32x16 y1 = MFMA32(tri[0], s10, carry); y1 = MFMA32(tri[1], s11, y1);
            f32x16 y0 = MFMA32(tri[0], s00, t1); y0 = MFMA32(tri[1], s01, y0);
            carry = MFMA32(ones, s00, t1); carry = MFMA32(ones, s01, carry);
            f32x16 w0, w1;
#pragma unroll
            for (int i = 0; i < 16; ++i) {
                const int key0 = kb0 + (i & 3) + 8 * (i >> 2);
                const float e0 = fexp2(st0[i] - sp0[i] - y0[i]), e1 = fexp2(st1[i] - sp1[i] - y1[i]);
                w0[i] = (key0 < qpos) ? e0 : 0.f; w1[i] = (key0 + 32 < qpos) ? e1 : 0.f;
            }
            bf16x8 pp[2][2]; pp[0][0] = pack8(w0, 0); pp[0][1] = pack8(w0, 1); pp[1][0] = pack8(w1, 0); pp[1][1] = pack8(w1, 1);
            pv_accum(oT, Vb + vlane_off, pp);
            wdone = __all(carry[0] >= SB_DONE) != 0;
        }
    }
    store_oT(F_OBR(F) + (rowbase + qpos) * 768 + hd * 64, oT, 1.0f, h);
}

constexpr int ML_KP = 208, ML_KT = 64 * ML_KP, ML_BUF = ML_KT + 64 * VP;
DI void mla_unit(Frame& F, int b, int hd, int qb) {
    const int lane = F.lane, r32 = lane & 31, h = lane >> 5, wave = F.wave;
    const int q0w = qb * 256 + wave * 32, qpos = q0w + r32;
    const size_t rowbase = (size_t)b * SEQ;
    const bf16* MQp = F_MQ(F); const bf16* P = F_PROJ(F);
    bf16x8 qf[6];
#pragma unroll
    for (int s = 0; s < 6; ++s) qf[s] = *(const bf16x8*)(MQp + (rowbase + qpos) * D + hd * 96 + 16 * s + 8 * h);
    f32x16 oT[2];
#pragma unroll
    for (int i = 0; i < 16; ++i) { oT[0][i] = 0.f; oT[1][i] = 0.f; }
    float mrun = -1e30f, lrun = 0.f;
    const int NT = 4 * (qb + 1);
    const int i0 = F.tid, i1 = F.tid + 512;
    const int r0 = i0 / 12, c0 = i0 % 12, r1 = i1 / 12, c1 = i1 % 12; const bool has1 = i1 < 768;
    const bf16* kg0 = (c0 < 8) ? MQp + (rowbase + r0) * D + 384 + hd * 128 + c0 * 8 : P + (rowbase + r0) * NPROJ + PJ_KR + (c0 - 8) * 8;
    const size_t ks0 = (c0 < 8) ? (size_t)64 * D : (size_t)64 * NPROJ;
    const bf16* kg1 = (c1 < 8) ? MQp + (rowbase + (has1 ? r1 : 0)) * D + 384 + hd * 128 + c1 * 8 : P + (rowbase + (has1 ? r1 : 0)) * NPROJ + PJ_KR + (c1 - 8) * 8;
    const size_t ks1 = (c1 < 8) ? (size_t)64 * D : (size_t)64 * NPROJ;
    const int vr = F.tid >> 3, vc = F.tid & 7;
    const bf16* vg = MQp + (rowbase + vr) * D + 384 + hd * 128 + 64 + vc * 8;
    u32x4 kreg0 = *(const u32x4*)kg0, kreg1 = (u32x4){0u, 0u, 0u, 0u}, vreg = *(const u32x4*)vg;
    if (has1) kreg1 = *(const u32x4*)kg1;
    const int kd0 = r0 * ML_KP + c0 * 16, kd1 = r1 * ML_KP + c1 * 16, vd = vr * VP + vc * 16;
    const int klane = r32 * ML_KP + 16 * h;
    const int vlane_off = (4 * h + ((lane & 15) >> 2)) * VP + ((lane >> 4) & 1) * 32 + (lane & 3) * 8;
    for (int kt = 0; kt < NT; ++kt) {
        LAS unsigned char* Kb = F.lds + (kt & 1) * ML_BUF; LAS unsigned char* Vb = Kb + ML_KT;
        *(LAS u32x4*)(Kb + kd0) = kreg0; if (has1) *(LAS u32x4*)(Kb + kd1) = kreg1; *(LAS u32x4*)(Vb + vd) = vreg;
        __syncthreads();
        if (kt + 1 < NT) { kreg0 = *(const u32x4*)(kg0 + (size_t)(kt + 1) * ks0); if (has1) kreg1 = *(const u32x4*)(kg1 + (size_t)(kt + 1) * ks1); vreg = *(const u32x4*)(vg + (size_t)(kt + 1) * 64 * D); }
        if (kt * 64 <= q0w + 31) {
            f32x16 st0, st1;
#pragma unroll
            for (int i = 0; i < 16; ++i) { st0[i] = 0.f; st1[i] = 0.f; }
#pragma unroll
            for (int s = 0; s < 6; ++s) {
                const bf16x8 k0 = *(const LAS bf16x8*)(Kb + klane + 32 * s), k1 = *(const LAS bf16x8*)(Kb + klane + 32 * ML_KP + 32 * s);
                st0 = MFMA32(k0, qf[s], st0); st1 = MFMA32(k1, qf[s], st1);
            }
            if (kt * 64 + 63 > q0w) {
                const int kb0 = kt * 64 + 4 * h;
#pragma unroll
                for (int i = 0; i < 16; ++i) { const int key0 = kb0 + (i & 3) + 8 * (i >> 2); if (key0 > qpos) st0[i] = -INFINITY; if (key0 + 32 > qpos) st1[i] = -INFINITY; }
            }
            bf16x8 pp[2][2];
            softmax_tile(st0, st1, mrun, lrun, oT, pp);
            pv_accum(oT, Vb + vlane_off, pp);
        }
    }
    const float ltot = lrun + __shfl_xor(lrun, 32);
    store_oT(F_OBR(F) + (rowbase + qpos) * 768 + 256 + hd * 64, oT, 1.0f / ltot, h);
}

template <int GI>
DI void dil_group(Frame& F, int b, int hd, int P0, int r32, int h, int lane, LAS unsigned char* Vw, float& mrun, float& lrun, f32x16 (&oT)[2]) {
    constexpr int SH = GI == 0 ? 0 : (GI == 1 ? 2 : 4), R = 1 << SH, STEP = 16 >> SH, NTILE = GI == 0 ? 10 : (GI == 1 ? 4 : 3), NSUB = SEQ >> SH;
    const bf16* P = F_PROJ(F);
    const size_t rowbase = (size_t)b * SEQ;
    const int rc = P0 & (R - 1), i0 = P0 >> SH, iq = i0 + STEP * r32, start = i0 - 128;
    const int qcol = PJ_DIL + GI * 768 + hd * 64, kcol = qcol + 256, vcol = qcol + 512;
    bf16x8 qf[4];
#pragma unroll
    for (int s = 0; s < 4; ++s) qf[s] = *(const bf16x8*)(P + (rowbase + P0 + 16 * r32) * NPROJ + qcol + 16 * s + 8 * h);
    const int vlane_off = (4 * h + ((lane & 15) >> 2)) * VP + ((lane >> 4) & 1) * 32 + (lane & 3) * 8;
    for (int kt = 0; kt < NTILE; ++kt) {
        const int kidx0 = start + 64 * kt;
        bf16x8 kf[2][4];
#pragma unroll
        for (int blk = 0; blk < 2; ++blk) {
            int kid = kidx0 + 32 * blk + r32; kid = kid < 0 ? 0 : (kid > NSUB - 1 ? NSUB - 1 : kid);
            const bf16* kp = P + (rowbase + rc + ((size_t)kid << SH)) * NPROJ + kcol + 8 * h;
#pragma unroll
            for (int s = 0; s < 4; ++s) kf[blk][s] = *(const bf16x8*)(kp + 16 * s);
        }
        u32x4 vv[8];
#pragma unroll
        for (int i = 0; i < 8; ++i) {
            int kid = kidx0 + (lane >> 3) + 8 * i; kid = kid < 0 ? 0 : (kid > NSUB - 1 ? NSUB - 1 : kid);
            vv[i] = *(const u32x4*)(P + (rowbase + rc + ((size_t)kid << SH)) * NPROJ + vcol + (lane & 7) * 8);
        }
        asm volatile("" ::: "memory");
#pragma unroll
        for (int i = 0; i < 8; ++i) *(LAS u32x4*)(Vw + ((lane >> 3) + 8 * i) * VP + (lane & 7) * 16) = vv[i];
        LDS_WAIT();
        f32x16 st0, st1;
#pragma unroll
        for (int i = 0; i < 16; ++i) { st0[i] = 0.f; st1[i] = 0.f; }
#pragma unroll
        for (int s = 0; s < 4; ++s) { st0 = MFMA32(kf[0][s], qf[s], st0); st1 = MFMA32(kf[1][s], qf[s], st1); }
#pragma unroll
        for (int i = 0; i < 16; ++i) {
            const int k0 = kidx0 + 4 * h + (i & 3) + 8 * (i >> 2), k1 = k0 + 32;
            if (!(k0 >= 0 && k0 <= iq && k0 >= iq - 128)) st0[i] = -INFINITY;
            if (!(k1 >= 0 && k1 <= iq && k1 >= iq - 128)) st1[i] = -INFINITY;
        }
        bf16x8 pp[2][2];
        softmax_tile(st0, st1, mrun, lrun, oT, pp);
        pv_accum(oT, Vw + vlane_off, pp);
        LDS_WAIT();
    }
}
DI void dil_unit(Frame& F, int b, int hd, int span, int half) {
    const int lane = F.lane, r32 = lane & 31, h = lane >> 5;
    const int P0 = span * 512 + 8 * half + F.wave;
    LAS unsigned char* Vw = F.lds + F.wave * (64 * VP);
    f32x16 oT[2];
#pragma unroll
    for (int i = 0; i < 16; ++i) { oT[0][i] = 0.f; oT[1][i] = 0.f; }
    float mrun = -1e30f, lrun = 0.f;
    dil_group<0>(F, b, hd, P0, r32, h, lane, Vw, mrun, lrun, oT);
    dil_group<1>(F, b, hd, P0, r32, h, lane, Vw, mrun, lrun, oT);
    dil_group<2>(F, b, hd, P0, r32, h, lane, Vw, mrun, lrun, oT);
    const float ltot = lrun + __shfl_xor(lrun, 32);
    store_oT(F_OBR(F) + ((size_t)b * SEQ + P0 + 16 * r32) * 768 + 512 + hd * 64, oT, 1.0f / ltot, h);
}

DI void attn_phase(Frame& F, int l) {
    unsigned* ctr = F_ctl(F) + CW_Q + 64 * l;
    volatile LAS unsigned* slot = (volatile LAS unsigned*)(F.lds + LDSCTL_OFF + LC_Q);
    constexpr unsigned NU = 768;
    for (;;) {
        if (F.tid == 0) *slot = __hip_atomic_fetch_add(ctr, 1u, __ATOMIC_RELAXED, __HIP_MEMORY_SCOPE_AGENT);
        __syncthreads();
        const unsigned u = (unsigned)__builtin_amdgcn_readfirstlane((int)*slot);
        __syncthreads();
        if (u >= NU) break;
        if (u < 512u) {
            const int qb = 31 - (int)(u >> 4), r = (int)(u & 15u), bh = r & 7, b = bh >> 2, hd = bh & 3;
            if (r < 8) sb_unit(F, b, hd, qb); else mla_unit(F, b, hd, qb);
        } else {
            const int j = (int)u - 512; dil_unit(F, j >> 7, (j >> 5) & 3, (j & 31) >> 1, j & 1);
        }
    }
}

constexpr int N_PHASES = 41;

__global__ void __launch_bounds__(512, 2) fwd_kernel(Args a) {
    extern __shared__ __attribute__((aligned(16))) unsigned char lds_raw[];
    {
        LAS unsigned* lc = (LAS unsigned*)((LAS unsigned char*)lds_raw + LDSCTL_OFF);
        for (int u = threadIdx.x; u < (LDS_BYTES - LDSCTL_OFF) / 4; u += 512) lc[u] = 0u;
    }
    __syncthreads();
    const int lo = a.ph_lo, hi = a.ph_hi;
    unsigned* const barw = (unsigned*)(a.ws + WS_CTL) + CW_BAR;
    XcdBarrier bar; bar.bar = barw; bar.x = 0; bar.st = nullptr;
    if (hi - lo > 1) bar = xcd_barrier_post(barw, (volatile LAS unsigned*)((LAS unsigned char*)lds_raw + LDSCTL_OFF + LC_XB));
#define IN(k) (lo <= (k) && (k) < hi)
#define SEAM(k) do { if (IN(k) && IN((k) + 1)) xcd_barrier(bar); } while (0)
#ifndef DUP_PHASE
#define DUP_PHASE -1
#endif
#define DUP(k) if (DUP_PHASE == (k) && IN(pb + (k)) && (xcd_barrier(bar), true))

    for (int l = 0; l < NLAYER; ++l) {
        const int pb = 10 * l;
        if (IN(pb + 0)) { Frame F = mkframe(); if (l == 0) pre_tables(F); conv_phase(F, l); norm_phase<false>(F, l, F_g_mix(F) + l * 1024); }
        DUP(0) { Frame F = mkframe(); conv_phase(F, l); }
        SEAM(pb + 0);
        if (IN(pb + 1)) {
            Frame F = mkframe();
            pg8::Gemm g{F_H(F), F_Win_t(F), 1024, 1024, 1024}; pg8::StaticOrder S; S.init(T, NPROJ, F.G, F.bx);
            EpiInproj E{F_PROJ(F), (const f32x4*)F_cs64(F), (const f32x4*)F_cs32(F), F_statq(F), F_statkv(F)};
            pg8::gemm_phase<EpiInproj, pg8::StaticOrder, true>(F.lds, F.tid, g, S, E);
        }
        DUP(1) {
            Frame F = mkframe();
            pg8::Gemm g{F_H(F), F_Win_t(F), 1024, 1024, 1024}; pg8::StaticOrder S; S.init(T, NPROJ, F.G, F.bx);
            EpiInproj E{F_PROJ(F), (const f32x4*)F_cs64(F), (const f32x4*)F_cs32(F), F_statq(F), F_statkv(F)};
            pg8::gemm_phase<EpiInproj, pg8::StaticOrder, true>(F.lds, F.tid, g, S, E);
        }
        SEAM(pb + 1);
        if (IN(pb + 2)) {
            Frame F = mkframe();
            pg8::Gemm g{F_PROJ(F) + PJ_MLA, F_Wup_t(F), NPROJ, 512, 512}; pg8::StaticOrder S; S.init(T, 1024, F.G, F.bx);
            EpiMlaUp E{F_MQ(F), (const f32x4*)F_statq(F), (const f32x4*)F_statkv(F), (const f32x4*)F_cs32(F)};
            pg8::gemm_phase<EpiMlaUp, pg8::StaticOrder, false>(F.lds, F.tid, g, S, E);
        }
        DUP(2) { Frame F = mkframe();
            pg8::Gemm g{F_PROJ(F) + PJ_MLA, F_Wup_t(F), NPROJ, 512, 512}; pg8::StaticOrder S; S.init(T, 1024, F.G, F.bx);
            EpiMlaUp E{F_MQ(F), (const f32x4*)F_statq(F), (const f32x4*)F_statkv(F), (const f32x4*)F_cs32(F)};
            pg8::gemm_phase<EpiMlaUp, pg8::StaticOrder, false>(F.lds, F.tid, g, S, E); }
        SEAM(pb + 2);
        if (IN(pb + 3)) { Frame F = mkframe(); attn_phase(F, l); }
        DUP(3) { Frame F = mkframe(); attn_phase(F, l + 4); }
        SEAM(pb + 3);
        if (IN(pb + 4)) {
            Frame F = mkframe();
            pg8::Gemm g{F_OBR(F), F_Wb_t(F), 768, 256, 256}; MergeOrder S{F.G, F.vcu};
            EpiMerge E{F_H(F), F_PROJ(F)};
            pg8::gemm_phase<EpiMerge, MergeOrder, false>(F.lds, F.tid, g, S, E);
        }
        DUP(4) { Frame F = mkframe();
            pg8::Gemm g{F_OBR(F), F_Wb_t(F), 768, 256, 256}; MergeOrder S{F.G, F.vcu};
            EpiMerge E{F_H(F), F_PROJ(F)};
            pg8::gemm_phase<EpiMerge, MergeOrder, false>(F.lds, F.tid, g, S, E); }
        SEAM(pb + 4);
        if (IN(pb + 5)) {
            Frame F = mkframe();
            pg8::Gemm g{F_H(F), F_Wout_t(F), 1024, 1024, 1024}; pg8::StaticOrder S; S.init(T, 1024, F.G, F.bx);
            EpiResid E{F.out};
            pg8::gemm_phase<EpiResid, pg8::StaticOrder, false>(F.lds, F.tid, g, S, E);
        }
        SEAM(pb + 5);
        if (IN(pb + 6)) { Frame F = mkframe(); route_phase(F, l); }
        DUP(6) { Frame F = mkframe(); route_phase(F, l); }
        SEAM(pb + 6);
        if (IN(pb + 7)) { Frame F = mkframe(); perm_phase(F); }
        DUP(7) { Frame F = mkframe(); perm_phase(F); }
        SEAM(pb + 7);
        if (IN(pb + 8)) {
            Frame F = mkframe();
            moe_tables(F);
            pg8::Gemm g{F_HPERM(F), F_W1_t(F), 1024, 1024, 1024}; MoeOrder S{(const LAS int*)(F.lds + LDSCTL_OFF + LC_TS), 2, F.G, F.vcu};
            EpiSwiglu E{F_HID(F)};
            pg8::gemm_phase<EpiSwiglu, MoeOrder, true>(F.lds, F.tid, g, S, E);
        }
        DUP(8) { Frame F = mkframe();
            moe_tables(F);
            pg8::Gemm g{F_HPERM(F), F_W1_t(F), 1024, 1024, 1024}; MoeOrder S{(const LAS int*)(F.lds + LDSCTL_OFF + LC_TS), 2, F.G, F.vcu};
            EpiSwiglu E{F_HID(F)};
            pg8::gemm_phase<EpiSwiglu, MoeOrder, true>(F.lds, F.tid, g, S, E); }
        SEAM(pb + 8);
        if (IN(pb + 9)) {
            Frame F = mkframe();
            moe_tables(F);
            pg8::Gemm g{F_HID(F), F_W2_t(F), 256, 256, 256}; MoeOrder S{(const LAS int*)(F.lds + LDSCTL_OFF + LC_TS), 4, F.G, F.vcu};
            EpiY E{F_YBUF(F)};
            pg8::gemm_phase<EpiY, MoeOrder, true>(F.lds, F.tid, g, S, E);
        }
        DUP(9) { Frame F = mkframe();
            moe_tables(F);
            pg8::Gemm g{F_HID(F), F_W2_t(F), 256, 256, 256}; MoeOrder S{(const LAS int*)(F.lds + LDSCTL_OFF + LC_TS), 4, F.G, F.vcu};
            EpiY E{F_YBUF(F)};
            pg8::gemm_phase<EpiY, MoeOrder, true>(F.lds, F.tid, g, S, E); }
        SEAM(pb + 9);
    }
    if (IN(40)) { Frame F = mkframe(); norm_phase<true>(F, NLAYER, F_g_final(F)); }
#undef IN
#undef SEAM
}

extern "C" void kernel_launch(void* const* d_in, const int* in_sizes, int n_in, void* d_out, int out_size, void* d_ws, size_t ws_size, hipStream_t stream) {
    static int grid = 0;
    if (grid == 0) {
        if (n_in != 19 || out_size != T * D || ws_size < WS_END) { fprintf(stderr, "kernel_launch: unexpected problem (n_in %d, out %d, ws %zu < %zu)\n", n_in, out_size, ws_size, (size_t)WS_END); grid = -1; return; }
        if (hipFuncSetAttribute((const void*)fwd_kernel, hipFuncAttributeMaxDynamicSharedMemorySize, LDS_BYTES) != hipSuccess) { fprintf(stderr, "kernel_launch: hipFuncSetAttribute failed\n"); grid = -1; return; }
        int per_cu = 0;
        if (hipOccupancyMaxActiveBlocksPerMultiprocessor(&per_cu, (const void*)fwd_kernel, 512, LDS_BYTES) != hipSuccess || per_cu < 1) fprintf(stderr, "kernel_launch: occupancy query reports %d blocks per CU\n", per_cu);
        (void)hipGetLastError();
        grid = 256;
    }
    if (grid < 0) return;
    (void)in_sizes;
    if (hipMemsetAsync((char*)d_ws + WS_CTL, 0, CTL_ZERO_BYTES, stream) != hipSuccess) return;
    Args a{};
    for (int i = 0; i < 19; ++i) a.in[i] = d_in[i];
    a.out = (float*)d_out; a.ws = (unsigned char*)d_ws;
#if MK_PER_PHASE
    for (int p = 0; p < N_PHASES; ++p) { a.ph_lo = p; a.ph_hi = p + 1; hipLaunchKernelGGL(fwd_kernel, dim3(grid), dim3(512), LDS_BYTES, stream, a); }
#else
    a.ph_lo = 0; a.ph_hi = N_PHASES;
    hipLaunchKernelGGL(fwd_kernel, dim3(grid), dim3(512), LDS_BYTES, stream, a);
#endif
}
```
